# Optimizing an MI355X kernel written in HIP

```python
import math
import jax, jax.numpy as jnp
from jax import lax
import numpy as np

D_MODEL = 1024
BATCH = 2
SEQ = 8192
DEPTH = 1

GRID_W = 64
HEAD_DIM = 64
NA_HEADS = 8
NA_WIDTH = NA_HEADS * HEAD_DIM
NA_KR_MAX = 8
NA_KC = 16
DA_HEADS = 4
DA_VDIM = 2 * HEAD_DIM
DA_QK = DA_HEADS * 2 * HEAD_DIM
DA_WIDTH = DA_HEADS * DA_VDIM
MIX_WIDTH = NA_WIDTH + DA_WIDTH
IN_COLS = 3 * NA_WIDTH + 2 * DA_QK + DA_WIDTH
D_FF = -(-8 * D_MODEL // (3 * 256)) * 256
ROPE_THETA = 10000.0
LN_EPS = 1e-5
BLOCK_Q = 128
ALPHA = (2.0 * DEPTH) ** 0.25
BETA = (8.0 * DEPTH) ** -0.25

kernel_name = "hybrid_natten_diffattn_deepnorm_adaln_encoder"


def lambda_init_for(layer_idx):
    return 0.8 - 0.6 * math.exp(-0.3 * (layer_idx - 1))


def layer_norm(x, g=None, b=None):
    xf = x.astype(jnp.float32)
    mu = jnp.mean(xf, axis=-1, keepdims=True)
    var = jnp.mean(jnp.square(xf - mu), axis=-1, keepdims=True)
    y = (xf - mu) * lax.rsqrt(var + LN_EPS)
    if g is not None:
        y = y * g.astype(jnp.float32) + b.astype(jnp.float32)
    return y.astype(x.dtype)


def rms_norm(x, g):
    xf = x.astype(jnp.float32)
    y = xf * lax.rsqrt(jnp.mean(jnp.square(xf), axis=-1, keepdims=True) + LN_EPS)
    return (y * g.astype(jnp.float32)).astype(x.dtype)


def rope(x):
    S_ = x.shape[1]
    half = HEAD_DIM // 2
    freqs = 1.0 / (ROPE_THETA ** (jnp.arange(half, dtype=jnp.float32) / half))
    ang = jnp.arange(S_, dtype=jnp.float32)[:, None] * freqs[None, :]
    cos = jnp.cos(ang)[None, :, None, None, :]
    sin = jnp.sin(ang)[None, :, None, None, :]
    xf = x.astype(jnp.float32)
    x1, x2 = xf[..., :half], xf[..., half:]
    return jnp.concatenate([x1 * cos - x2 * sin, x2 * cos + x1 * sin], axis=-1).astype(x.dtype)


def neighbourhood_attention(q, k, v, rpb):
    B_, S_ = q.shape[0], q.shape[1]
    rows = S_ // GRID_W
    kr = min(NA_KR_MAX, rows)
    scale = HEAD_DIM ** -0.5

    def to_grid(t):
        return t.reshape(B_, rows, GRID_W, NA_HEADS, HEAD_DIM).transpose(1, 0, 3, 2, 4)

    q_g, k_g, v_g = to_grid(q), to_grid(k), to_grid(v)
    col = np.arange(GRID_W)
    col_start = np.clip(col - NA_KC // 2, 0, GRID_W - NA_KC)
    col_idx = col_start[:, None] + np.arange(NA_KC)[None, :]
    col_rel = col_idx - col[:, None] + (NA_KC - 1)
    rpb_cols = rpb[:, :, col_rel]

    def one_row(args):
        q_row, r = args
        rs = jnp.clip(r - kr // 2, 0, rows - kr)
        k_rows = lax.dynamic_slice_in_dim(k_g, rs, kr, axis=0)
        v_rows = lax.dynamic_slice_in_dim(v_g, rs, kr, axis=0)
        k_win = k_rows[:, :, :, col_idx]
        v_win = v_rows[:, :, :, col_idx]
        row_rel = rs + jnp.arange(kr) - r + (NA_KR_MAX - 1)
        bias = rpb_cols[:, row_rel].transpose(0, 2, 1, 3)
        s = jnp.einsum('bhwd,rbhwkd->bhwrk', q_row, k_win).astype(jnp.float32) * scale
        s = s + bias[None].astype(jnp.float32)
        p = jax.nn.softmax(s.reshape(B_, NA_HEADS, GRID_W, kr * NA_KC), axis=-1)
        p = p.reshape(B_, NA_HEADS, GRID_W, kr, NA_KC).astype(v.dtype)
        return jnp.einsum('bhwrk,rbhwkd->bhwd', p, v_win)

    out = lax.map(one_row, (q_g, jnp.arange(rows)))
    return out.transpose(1, 0, 3, 2, 4).reshape(B_, S_, NA_WIDTH)


def differential_attention(q, k, v, lam, subln_g, lambda_init):
    B_, S_ = q.shape[0], q.shape[1]
    nblk = S_ // BLOCK_Q
    scale = HEAD_DIM ** -0.5
    qb = q.reshape(B_, nblk, BLOCK_Q, DA_HEADS, 2, HEAD_DIM).transpose(1, 0, 3, 4, 2, 5)
    kt = k.transpose(0, 2, 3, 1, 4)
    vt = v.transpose(0, 2, 1, 3)

    def one_block(q_blk):
        s = jnp.einsum('bhiqd,bhikd->bhiqk', q_blk, kt).astype(jnp.float32) * scale
        p = jax.nn.softmax(s, axis=-1)
        a = p[:, :, 0] - lam * p[:, :, 1]
        return jnp.einsum('bhqk,bhke->bhqe', a.astype(vt.dtype), vt)

    o = lax.map(one_block, qb)
    o = o.transpose(1, 0, 3, 2, 4).reshape(B_, S_, DA_HEADS, DA_VDIM)
    o = rms_norm(o, subln_g) * (1.0 - lambda_init)
    return o.reshape(B_, S_, DA_WIDTH)


def setup_inputs(seed: int = 0) -> dict:
    key = jax.random.key(seed)
    ks = jax.random.split(key, 20)
    f32 = jnp.float32
    n = lambda k, shape, s: jax.random.normal(k, shape, f32) * s
    return {
        "x": n(ks[0], (BATCH, SEQ, D_MODEL), 1.0),
        "c": n(ks[1], (BATCH, D_MODEL), 1.0),
        "w_ada": n(ks[2], (DEPTH, D_MODEL, 6 * D_MODEL), 0.1 * D_MODEL ** -0.5),
        "b_ada": n(ks[3], (DEPTH, 6 * D_MODEL), 0.01),
        "w_in": n(ks[4], (DEPTH, D_MODEL, IN_COLS), D_MODEL ** -0.5),
        "rpb": n(ks[5], (DEPTH, NA_HEADS, 2 * NA_KR_MAX - 1, 2 * NA_KC - 1), 0.1),
        "lambda_q1": n(ks[6], (DEPTH, HEAD_DIM), 0.1),
        "lambda_k1": n(ks[7], (DEPTH, HEAD_DIM), 0.1),
        "lambda_q2": n(ks[8], (DEPTH, HEAD_DIM), 0.1),
        "lambda_k2": n(ks[9], (DEPTH, HEAD_DIM), 0.1),
        "subln_g": 1.0 + n(ks[10], (DEPTH, DA_VDIM), 0.02),
        "w_out": n(ks[11], (DEPTH, MIX_WIDTH, D_MODEL), BETA * MIX_WIDTH ** -0.5),
        "ln1_g": 1.0 + n(ks[12], (DEPTH, D_MODEL), 0.02),
        "ln1_b": n(ks[13], (DEPTH, D_MODEL), 0.02),
        "w_gate": n(ks[14], (DEPTH, D_MODEL, D_FF), D_MODEL ** -0.5),
        "w_up": n(ks[15], (DEPTH, D_MODEL, D_FF), D_MODEL ** -0.5),
        "w_down": n(ks[16], (DEPTH, D_FF, D_MODEL), BETA * D_FF ** -0.5),
        "ln2_g": 1.0 + n(ks[17], (DEPTH, D_MODEL), 0.02),
        "ln2_b": n(ks[18], (DEPTH, D_MODEL), 0.02),
    }


def reference(x, c, w_ada, b_ada, w_in, rpb, lambda_q1, lambda_k1, lambda_q2, lambda_k2,
              subln_g, w_out, ln1_g, ln1_b, w_gate, w_up, w_down, ln2_g, ln2_b):
    B_, S_, _ = x.shape
    c_act = jax.nn.silu(c)
    for l in range(DEPTH):
        lambda_init = lambda_init_for(l + 1)
        mod = c_act @ w_ada[l] + b_ada[l]
        shift1, scale1, gate1, shift2, scale2, gate2 = [m[:, None, :] for m in jnp.split(mod, 6, axis=-1)]

        h = layer_norm(x) * (1.0 + scale1) + shift1
        proj = h @ w_in[l]
        o1 = NA_WIDTH; o2 = 2 * NA_WIDTH; o3 = 3 * NA_WIDTH
        o4 = o3 + DA_QK; o5 = o4 + DA_QK
        na_q = proj[..., :o1].reshape(B_, S_, NA_HEADS, HEAD_DIM)
        na_k = proj[..., o1:o2].reshape(B_, S_, NA_HEADS, HEAD_DIM)
        na_v = proj[..., o2:o3].reshape(B_, S_, NA_HEADS, HEAD_DIM)
        da_q = rope(proj[..., o3:o4].reshape(B_, S_, DA_HEADS, 2, HEAD_DIM))
        da_k = rope(proj[..., o4:o5].reshape(B_, S_, DA_HEADS, 2, HEAD_DIM))
        da_v = proj[..., o5:].reshape(B_, S_, DA_HEADS, DA_VDIM)

        out_a = neighbourhood_attention(na_q, na_k, na_v, rpb[l])
        lam = (jnp.exp(jnp.sum(lambda_q1[l].astype(jnp.float32) * lambda_k1[l].astype(jnp.float32)))
               - jnp.exp(jnp.sum(lambda_q2[l].astype(jnp.float32) * lambda_k2[l].astype(jnp.float32)))
               + lambda_init)
        out_b = differential_attention(da_q, da_k, da_v, lam, subln_g[l], lambda_init)
        mix = jnp.concatenate([out_a, out_b], axis=-1) @ w_out[l]
        x = layer_norm(ALPHA * x + (1.0 + gate1) * mix, ln1_g[l], ln1_b[l])

        h = layer_norm(x) * (1.0 + scale2) + shift2
        ffn = (jax.nn.silu(h @ w_gate[l]) * (h @ w_up[l])) @ w_down[l]
        x = layer_norm(ALPHA * x + (1.0 + gate2) * ffn, ln2_g[l], ln2_b[l])
    return x
```

```cpp
#include <hip/hip_runtime.h>
#include <cstdio>
#include <cstdint>
#include <cmath>

#ifndef MK_N_LAUNCHES
#define MK_N_LAUNCHES 10
#endif

constexpr int BATCH = 2, SEQ = 8192, DM = 1024, M = BATCH * SEQ;
constexpr int GRID_W = 64, NA_HEADS = 8, HD = 64, NA_KR = 8, NA_KC = 16, ROWS = SEQ / GRID_W;
constexpr int DA_HEADS = 4, DA_V = 128;
constexpr int INC = 3072, DFF = 2816, NGU = 2 * DFF;
constexpr int O_NAQ = 0, O_NAK = 512, O_NAV = 1024, O_DAQ = 1536, O_DAK = 2048, O_DAV = 2560;
constexpr float LN_EPS = 1e-5f;
constexpr float ALPHA = 1.189207115002721f;
constexpr float LAMBDA_INIT = 0.2f;
constexpr float C2 = 0.125f * 1.4426950408889634f;

namespace pg8 {
#define PG8_LAS __attribute__((address_space(3)))
typedef unsigned short bf16_t;
typedef short bf16x8 __attribute__((ext_vector_type(8)));
typedef float f32x4 __attribute__((ext_vector_type(4)));
typedef unsigned u32x4 __attribute__((ext_vector_type(4)));
constexpr int BM = 256, BK = 64, HALF = 128, HTB = HALF * BK * 2, STAGE_BYTES = 8 * HTB, NXCD = 8, WGM = 8;

__host__ __device__ __forceinline__ int lds_byte(int r, int c) { const int st = (r >> 4) * 2 + (c >> 5), rr = r & 15, cc = c & 31, ob = rr * 64 + cc * 2; return st * 1024 + (ob ^ (((ob >> 9) & 1) << 5)); }
__host__ __device__ __forceinline__ void stage_rc(int b, int& R, int& C) { const int st = b / 1024, sb = b % 1024, swz = sb ^ (((sb >> 9) & 1) << 5); R = (st >> 1) * 16 + swz / 64; C = (st & 1) * 32 + (swz % 64) / 2; }
__host__ __device__ __forceinline__ int perm32(int rho) { const int n = rho >> 4, i = rho & 15; return 8 * (i >> 2) + 4 * n + (i & 3); }

struct Unit { int pm, pn; };
struct Gemm { const bf16_t* A; const bf16_t* Bt; int M, N, K; };

struct StaticOrder {
    int nM, nN, nwg, G, c;
    __host__ __device__ void init(int M_, int N_, int G_, int c_) { nM = M_ / BM; nN = N_ / BM; nwg = nM * nN; G = G_; c = c_; }
    __host__ __device__ bool next(int i, Unit& u) const {
        const long L = (long)i * G + c; if (L >= nwg) return false;
        int wgid = (int)L; { const int q = nwg / NXCD, r = nwg % NXCD, xcd = wgid % NXCD, off = wgid / NXCD; wgid = (xcd < r ? xcd * (q + 1) : r * (q + 1) + (xcd - r) * q) + off; }
        const int nig = WGM * nN, gid = wgid / nig, fm = gid * WGM, gsz = (nM - fm) < WGM ? (nM - fm) : WGM;
        u.pm = fm + ((wgid % nig) % gsz); u.pn = (wgid % nig) / gsz; return true;
    }
    __device__ __forceinline__ void a_ready(const Unit&) const {}
    __device__ __forceinline__ void done(const Unit&) const {}
};

template <class F> struct EpiFn {
    static constexpr bool PERM = false, AFTER_DRAIN = false; F f;
    __device__ __forceinline__ void operator()(const f32x4 (&acc)[2][2][4][2], const Unit& u, int wr, int wc, int fr, int fq) const {
#pragma unroll
        for (int ai = 0; ai < 2; ++ai)
#pragma unroll
            for (int m = 0; m < 4; ++m) { const int row = u.pm * BM + ai * HALF + wr * 64 + m * 16 + fr;
#pragma unroll
                for (int bj = 0; bj < 2; ++bj)
#pragma unroll
                    for (int n = 0; n < 2; ++n) f(row, u.pn * BM + bj * HALF + wc * 32 + n * 16 + 4 * fq, acc[ai][bj][m][n], u.pn); }
    }
    __device__ __forceinline__ void fused(f32x4 (&)[2][2][4][2], const Unit&, int, int, int, int, PG8_LAS unsigned char*, int, int) const {}
};

template <class Epi, class Sched, bool ALIGN_EPI = false, bool SP2 = false>
__device__ __forceinline__ void gemm_phase(PG8_LAS unsigned char* lds, const Gemm g, const Sched& S, const Epi& E) {
    const int tid = threadIdx.x, wid = __builtin_amdgcn_readfirstlane(tid >> 6), lane = tid & 63, wr = wid >> 2, wc = wid & 3, fr = lane & 15, fq = lane >> 4;
    const int K = g.K, nt = K / BK;
    unsigned voffA[2], voffB[2];
#pragma unroll
    for (int i = 0; i < 2; ++i) { int R, C; stage_rc(tid * 16 + i * 8192, R, C); const int Rb = Epi::PERM ? ((R & ~31) + perm32(R & 31)) : R;
        voffA[i] = (unsigned)(R * K + C) * 2u; voffB[i] = (unsigned)(Rb * K + C) * 2u; }
    const size_t kstep = (size_t)(BK * 2);
    const size_t hstep = (size_t)HALF * K * 2;
    const size_t tstep = 2 * hstep;
    const unsigned ldsw = (unsigned)wid * 1024u;
    const int aoff = lds_byte(wr * 64 + fr, fq * 8), boff = lds_byte(wc * 32 + fr, fq * 8);
#define PG8_SA(b, h) (((b) * 2 + (h)) * HTB)
#define PG8_SB(b, h) ((4 + (b) * 2 + (h)) * HTB)
#define PG8_STAGE(bufoff, gbase, voff) do { _Pragma("unroll") for (int _i = 0; _i < 2; ++_i) \
        __builtin_amdgcn_global_load_lds((const unsigned*)((const char*)(gbase) + (voff)[_i]), (PG8_LAS unsigned*)(lds + (bufoff) + ldsw + _i * 8192), 16, 0, 0); } while (0)
#define PG8_LDA(dst, b, h) do { _Pragma("unroll") for (int m = 0; m < 4; ++m) _Pragma("unroll") for (int k = 0; k < 2; ++k) dst[m][k] = *(const PG8_LAS bf16x8*)(lds + PG8_SA(b, h) + aoff + m * 2048 + k * 1024); } while (0)
#define PG8_LDB(dst, b, h) do { _Pragma("unroll") for (int n = 0; n < 2; ++n) _Pragma("unroll") for (int k = 0; k < 2; ++k) dst[n][k] = *(const PG8_LAS bf16x8*)(lds + PG8_SB(b, h) + boff + n * 2048 + k * 1024); } while (0)
#define PG8_MMA(ai, bj, At, Bt) do { __builtin_amdgcn_s_setprio(1); _Pragma("unroll") for (int m = 0; m < 4; ++m) _Pragma("unroll") for (int n = 0; n < 2; ++n) _Pragma("unroll") for (int k = 0; k < 2; ++k) \
        acc[ai][bj][m][n] = __builtin_amdgcn_mfma_f32_16x16x32_bf16(Bt[n][k], At[m][k], acc[ai][bj][m][n], 0, 0, 0); __builtin_amdgcn_s_setprio(0); } while (0)
#define PG8_WAIT_V(n) asm volatile("s_waitcnt vmcnt(" #n ")" ::: "memory")
#define PG8_WAIT_L(n) asm volatile("s_waitcnt lgkmcnt(" #n ")" ::: "memory")
#define PG8_BAR __builtin_amdgcn_s_barrier()
#define PG8_SCHED __builtin_amdgcn_sched_barrier(0)
    Unit cur, nxt; int ui = 0;
    if (!S.next(0, cur)) return;
    f32x4 acc[2][2][4][2];
#pragma unroll
    for (int a = 0; a < 2; ++a)
#pragma unroll
        for (int b = 0; b < 2; ++b)
#pragma unroll
            for (int m = 0; m < 4; ++m)
#pragma unroll
                for (int n = 0; n < 2; ++n) acc[a][b][m][n] = (f32x4){0.f, 0.f, 0.f, 0.f};
    bf16x8 At[4][2], B0[2][2], B1[2][2];
    const char* cA = (const char*)g.A + (size_t)cur.pm * tstep; const char* cB = (const char*)g.Bt + (size_t)cur.pn * tstep;
    S.a_ready(cur);
    if constexpr (SP2) {
        PG8_STAGE(PG8_SB(0, 0), cB, voffB); PG8_STAGE(PG8_SB(0, 1), cB + hstep, voffB); PG8_STAGE(PG8_SA(0, 0), cA, voffA); PG8_STAGE(PG8_SA(0, 1), cA + hstep, voffA);
        if (wr == 1) PG8_BAR;
        PG8_WAIT_V(2); PG8_BAR;
        PG8_STAGE(PG8_SB(1, 0), cB + kstep, voffB); PG8_STAGE(PG8_SA(1, 0), cA + kstep, voffA); PG8_STAGE(PG8_SB(1, 1), cB + hstep + kstep, voffB);
        PG8_WAIT_V(6); PG8_BAR;
    } else {
        PG8_STAGE(PG8_SB(0, 0), cB, voffB); PG8_STAGE(PG8_SA(0, 0), cA, voffA); PG8_STAGE(PG8_SB(0, 1), cB + hstep, voffB); PG8_STAGE(PG8_SA(0, 1), cA + hstep, voffA);
        if (wr == 1) PG8_BAR;
        PG8_WAIT_V(4); PG8_BAR;
        PG8_STAGE(PG8_SB(1, 0), cB + kstep, voffB); PG8_STAGE(PG8_SA(1, 0), cA + kstep, voffA); PG8_STAGE(PG8_SB(1, 1), cB + hstep + kstep, voffB);
        PG8_WAIT_V(6); PG8_BAR;
    }
    for (;;) {
        const bool has_next = S.next(ui + 1, nxt);
        const char* nA = has_next ? (const char*)g.A + (size_t)nxt.pm * tstep : cA; const char* nB = has_next ? (const char*)g.Bt + (size_t)nxt.pn * tstep : cB;
        for (int t = 0; t < nt; t += 2) {
            const bool last = (t == nt - 2);
            const char* a1 = cA + (size_t)(t + 1) * kstep;
            const char* a2 = last ? nA : cA + (size_t)(t + 2) * kstep; const char* b2 = last ? nB : cB + (size_t)(t + 2) * kstep;
            const char* a3 = a2 + kstep; const char* b3 = b2 + kstep;
            if (last && has_next) S.a_ready(nxt);
            if constexpr (SP2) {
            PG8_LDB(B0, 0, 0); PG8_LDB(B1, 0, 1); PG8_SCHED; PG8_LDA(At, 0, 0); PG8_STAGE(PG8_SA(1, 1), a1 + hstep, voffA);
            PG8_WAIT_V(8); PG8_WAIT_L(0); PG8_BAR; PG8_MMA(0, 0, At, B0); PG8_MMA(0, 1, At, B1); PG8_BAR; PG8_SCHED;
            PG8_LDA(At, 0, 1); PG8_STAGE(PG8_SB(0, 0), b2, voffB); PG8_STAGE(PG8_SB(0, 1), b2 + hstep, voffB); PG8_STAGE(PG8_SA(0, 0), a2, voffA);
            PG8_WAIT_V(8); PG8_WAIT_L(0); PG8_BAR; PG8_MMA(1, 0, At, B0); PG8_MMA(1, 1, At, B1); PG8_BAR; PG8_SCHED;
            PG8_LDB(B0, 1, 0); PG8_LDB(B1, 1, 1); PG8_SCHED; PG8_LDA(At, 1, 0); PG8_STAGE(PG8_SA(0, 1), a2 + hstep, voffA);
            PG8_WAIT_V(8); PG8_WAIT_L(0); PG8_BAR; PG8_MMA(0, 0, At, B0); PG8_MMA(0, 1, At, B1); PG8_BAR; PG8_SCHED;
            PG8_LDA(At, 1, 1); PG8_STAGE(PG8_SB(1, 0), b3, voffB); PG8_STAGE(PG8_SB(1, 1), b3 + hstep, voffB); PG8_STAGE(PG8_SA(1, 0), a3, voffA);
            PG8_WAIT_V(8); PG8_WAIT_L(0); PG8_BAR; PG8_MMA(1, 0, At, B0); PG8_MMA(1, 1, At, B1); PG8_BAR; PG8_SCHED;
            } else {
            PG8_LDB(B0, 0, 0); PG8_SCHED; PG8_LDA(At, 0, 0); PG8_STAGE(PG8_SA(1, 1), a1 + hstep, voffA);
            PG8_WAIT_L(8); PG8_BAR; PG8_WAIT_L(0); PG8_MMA(0, 0, At, B0); PG8_BAR; PG8_SCHED;
            PG8_LDB(B1, 0, 1); PG8_STAGE(PG8_SB(0, 0), b2, voffB);
            PG8_BAR; PG8_WAIT_L(0); PG8_MMA(0, 1, At, B1); PG8_BAR;
            PG8_LDA(At, 0, 1); PG8_STAGE(PG8_SA(0, 0), a2, voffA);
            PG8_BAR; PG8_WAIT_L(0); PG8_MMA(1, 0, At, B0); PG8_BAR; PG8_SCHED;
            PG8_STAGE(PG8_SB(0, 1), b2 + hstep, voffB);
            PG8_WAIT_V(6); PG8_BAR; PG8_MMA(1, 1, At, B1); PG8_BAR;
            PG8_LDB(B0, 1, 0); PG8_SCHED; PG8_LDA(At, 1, 0); PG8_STAGE(PG8_SA(0, 1), a2 + hstep, voffA);
            PG8_WAIT_L(8); PG8_BAR; PG8_WAIT_L(0); PG8_MMA(0, 0, At, B0); PG8_BAR; PG8_SCHED;
            PG8_LDB(B1, 1, 1); PG8_STAGE(PG8_SB(1, 0), b3, voffB);
            PG8_BAR; PG8_WAIT_L(0); PG8_MMA(0, 1, At, B1); PG8_BAR;
            PG8_LDA(At, 1, 1); PG8_STAGE(PG8_SA(1, 0), a3, voffA);
            PG8_BAR; PG8_WAIT_L(0); PG8_MMA(1, 0, At, B0); PG8_BAR; PG8_SCHED;
            PG8_STAGE(PG8_SB(1, 1), b3 + hstep, voffB);
            PG8_WAIT_V(6); PG8_BAR; PG8_MMA(1, 1, At, B1); PG8_BAR;
            }
        }
        if constexpr (ALIGN_EPI) { if (wr == 0) PG8_BAR; }
        if constexpr (!Epi::AFTER_DRAIN) { E(acc, cur, wr, wc, fr, fq); S.done(cur); }
        if (!has_next) break;
#pragma unroll
        for (int a = 0; a < 2; ++a)
#pragma unroll
            for (int b = 0; b < 2; ++b)
#pragma unroll
                for (int m = 0; m < 4; ++m)
#pragma unroll
                    for (int n = 0; n < 2; ++n) acc[a][b][m][n] = (f32x4){0.f, 0.f, 0.f, 0.f};
        cur = nxt; cA = nA; cB = nB; ++ui;
        if constexpr (ALIGN_EPI) { if (wr == 1) PG8_BAR; }
    }
    PG8_WAIT_V(0);
    if constexpr (!ALIGN_EPI) { if (wr == 0) PG8_BAR; }
    PG8_BAR;
    if constexpr (Epi::AFTER_DRAIN) { E.fused(acc, cur, wr, wc, fr, fq, lds, wid, lane); S.done(cur); }
#undef PG8_SA
#undef PG8_SB
#undef PG8_STAGE
#undef PG8_LDA
#undef PG8_LDB
#undef PG8_MMA
#undef PG8_WAIT_V
#undef PG8_WAIT_L
#undef PG8_BAR
#undef PG8_SCHED
}
}

constexpr int NWAVES = 8, NTHR = NWAVES * 64;
constexpr int N_PHASES = 10;
constexpr size_t MiB = 1u << 20;
constexpr size_t WS_CTL = 0, CTL_ZERO_BYTES = 64 * 1024;
constexpr size_t WS_MOD = 1 * MiB;
constexpr size_t WS_ROPE = 2 * MiB;
constexpr size_t WS_WIN = 4 * MiB;
constexpr size_t WS_WOUT = 10 * MiB;
constexpr size_t WS_WGU = 12 * MiB;
constexpr size_t WS_WD = 23 * MiB;
constexpr size_t WS_XN = 32 * MiB;
constexpr size_t WS_PROJ = 64 * MiB;
constexpr size_t WS_H = WS_PROJ;
constexpr size_t WS_CAT = 160 * MiB;
constexpr size_t WS_END = 192 * MiB;
constexpr int CW_BAR = 1024;
constexpr int RING_BYTES = 131072, LDSCTL_OFF = RING_BYTES, MISC_OFF = LDSCTL_OFF + 320, LDS_BYTES = 147456;

#define GAS __attribute__((address_space(1)))
#define LAS __attribute__((address_space(3)))
typedef unsigned short bf16;
typedef unsigned v4u __attribute__((ext_vector_type(4)));
typedef unsigned v2u __attribute__((ext_vector_type(2)));
typedef float f32x4 __attribute__((ext_vector_type(4)));
typedef float f32x2 __attribute__((ext_vector_type(2)));
#define LDS_WAIT() asm volatile("s_waitcnt lgkmcnt(0)" ::: "memory")
#define VM_WAIT() asm volatile("s_waitcnt vmcnt(0)" ::: "memory")
__device__ __forceinline__ unsigned f2bf(float f) { unsigned u = __builtin_bit_cast(unsigned, f); return (u + 0x7fffu + ((u >> 16) & 1u)) >> 16; }
__device__ __forceinline__ unsigned pk2(float lo, float hi) { return f2bf(lo) | (f2bf(hi) << 16); }
__device__ __forceinline__ float bflo(unsigned w) { return __builtin_bit_cast(float, w << 16); }
__device__ __forceinline__ float bfhi(unsigned w) { return __builtin_bit_cast(float, w & 0xffff0000u); }
__device__ __forceinline__ float wave_sum(float v) {
#pragma unroll
    for (int o = 1; o < 64; o <<= 1) v += __shfl_xor(v, o);
    return v;
}

#define XB_TMO      128
#define XB_XCNT(j)  (256  + 64 * (j))
#define XB_XSUB(j)  (1280 + 64 * (j))
#define XB_XGEN(j)  (2304 + 64 * (j))
#define XB_TOP      3328
#define XB_TOPGEN   3392
#define XCD_BAR_WORDS 3456
#define XB_SPIN_CAP (1u << 18)
__device__ __forceinline__ unsigned xb_ld(unsigned* p)              { return __hip_atomic_load(p, __ATOMIC_RELAXED, __HIP_MEMORY_SCOPE_AGENT); }
__device__ __forceinline__ unsigned xb_add(unsigned* p, unsigned v) { return __hip_atomic_fetch_add(p, v, __ATOMIC_RELAXED, __HIP_MEMORY_SCOPE_AGENT); }
__device__ __forceinline__ unsigned xb_xcc_id() { return (unsigned)__builtin_amdgcn_s_getreg((3 << 11) | 20) & 0xFu; }
#define XB_SPIN(cond, bar) do { unsigned _sp = 0; while (cond) { __builtin_amdgcn_s_sleep(1); \
    if ((++_sp & 255u) == 0u) { if (xb_ld(&(bar)[XB_TMO])) break; if (_sp > XB_SPIN_CAP) { atomicAdd(&(bar)[XB_TMO], 1u); break; } } } } while (0)
struct XcdBarrier { unsigned* bar; unsigned x; volatile LAS unsigned* st; };
__device__ __forceinline__ XcdBarrier xcd_barrier_post(unsigned* bar, volatile LAS unsigned* st) {
    XcdBarrier b; b.bar = bar; b.x = xb_xcc_id(); b.st = st;
    if (threadIdx.x == 0) (void)xb_add(&bar[XB_XCNT(b.x)], 1u);
    return b;
}
__device__ __forceinline__ void xcd_barrier_complete(unsigned* bar, unsigned x, unsigned& nloc, unsigned& nx) {
    const unsigned G = gridDim.x * gridDim.y * gridDim.z;
    unsigned sum, cnt, mine, sp = 0u;
    for (;;) {
        sum = 0u; cnt = 0u; mine = 0u;
#pragma unroll
        for (unsigned j = 0; j < 16; ++j) { const unsigned c = xb_ld(&bar[XB_XCNT(j)]); sum += c; cnt += (c > 0u) ? 1u : 0u; mine = (j == x) ? c : mine; }
        if (sum == G) break;
        __builtin_amdgcn_s_sleep(1);
        if ((++sp & 255u) == 0u) { if (xb_ld(&bar[XB_TMO])) break; if (sp > XB_SPIN_CAP) { atomicAdd(&bar[XB_TMO], 1u); break; } }
    }
    nloc = mine > 0u ? mine : 1u; nx = cnt > 0u ? cnt : 1u;
}
__device__ __forceinline__ void xcd_barrier(const XcdBarrier& b) {
    asm volatile("s_waitcnt vmcnt(0)" ::: "memory");
    __syncthreads();
    if (threadIdx.x == 0) {
        unsigned* bar = b.bar;
        __builtin_amdgcn_s_waitcnt(0);
        unsigned nloc = b.st[0], nx = b.st[1];
        if (nloc == 0u) { xcd_barrier_complete(bar, b.x, nloc, nx); b.st[0] = nloc; b.st[1] = nx; }
        const unsigned old = xb_add(&bar[XB_XSUB(b.x)], 1u);
        const unsigned gen = old / nloc;
        if (old + 1u == (gen + 1u) * nloc) {
            __builtin_amdgcn_fence(__ATOMIC_RELEASE, "agent");
            asm volatile("s_waitcnt vmcnt(0)" ::: "memory");
            const unsigned og = xb_add(&bar[XB_TOP], 1u);
            const unsigned tg = og / nx;
            if (og + 1u == (tg + 1u) * nx) xb_add(&bar[XB_TOPGEN], 1u);
            else XB_SPIN(xb_ld(&bar[XB_TOPGEN]) == tg, bar);
            __builtin_amdgcn_fence(__ATOMIC_ACQUIRE, "agent");
            xb_add(&bar[XB_XGEN(b.x)], 1u);
            asm volatile("s_waitcnt vmcnt(0)" ::: "memory");
        } else {
            XB_SPIN(xb_ld(&bar[XB_XGEN(b.x)]) == gen, bar);
            __builtin_amdgcn_fence(__ATOMIC_ACQUIRE, "agent");
            asm volatile("s_waitcnt vmcnt(0)" ::: "memory");
        }
    }
    __syncthreads();
}

struct Args {
    const float* x; const float* c; const float* w_ada; const float* b_ada; const float* w_in; const float* rpb;
    const float* lq1; const float* lk1; const float* lq2; const float* lk2; const float* subln_g; const float* w_out;
    const float* ln1_g; const float* ln1_b; const float* w_gate; const float* w_up; const float* w_down; const float* ln2_g; const float* ln2_b;
    float* out; unsigned char* ws; int ph_lo, ph_hi; float freq[32];
};

__device__ __forceinline__ int dst_row(int mat, int n) {
    if (mat == 0) { if (n < O_DAQ || n >= O_DAV) return n; const int d = n & 63; return (n & ~63) + (d < 32 ? 2 * d : 2 * (d - 32) + 1); }
    if (mat == 2) return 2 * n;
    if (mat == 3) return 2 * n + 1;
    return n;
}
__device__ __forceinline__ void p0_transpose_item(const float* W, int K, int N, bf16* WT, int mat, LAS float* scr, int item, int lane) {
    const int nblk = N / 32, kb = item / nblk, nb = item % nblk, k0 = 64 * kb, n0 = 32 * nb;
#pragma unroll 8
    for (int i = 0; i < 32; ++i) { const int kk = 2 * i + (lane >> 5); scr[kk * 33 + (lane & 31)] = W[(size_t)(k0 + kk) * N + n0 + (lane & 31)]; }
    LDS_WAIT(); asm volatile("" ::: "memory");
    const int c = lane & 7;
#pragma unroll
    for (int j = 0; j < 4; ++j) { const int n = (lane >> 3) + 8 * j; const LAS float* s = scr + (8 * c) * 33 + n;
        v4u o; o.x = pk2(s[0 * 33], s[1 * 33]); o.y = pk2(s[2 * 33], s[3 * 33]); o.z = pk2(s[4 * 33], s[5 * 33]); o.w = pk2(s[6 * 33], s[7 * 33]);
        *(GAS v4u*)(WT + (size_t)dst_row(mat, n0 + n) * K + k0 + 8 * c) = o; }
    LDS_WAIT(); asm volatile("" ::: "memory");
}
__device__ __forceinline__ void sincos_d(double a, float& co, float& si) {
    const double k = __builtin_rint(a * 0.63661977236758134308);
    const double r = __builtin_fma(-k, 1.57079632679489661923, a) - k * 6.123233995736766e-17;
    const double r2 = r * r;
    double s = -2.5052108385441718775e-8; s = s * r2 + 2.7557319223985890653e-6; s = s * r2 - 1.9841269841269841270e-4; s = s * r2 + 8.3333333333333333333e-3; s = s * r2 - 1.6666666666666666667e-1; s = s * r2 * r + r;
    double c = 2.0876756987868098979e-9; c = c * r2 - 2.7557319223985890653e-7; c = c * r2 + 2.4801587301587301587e-5; c = c * r2 - 1.3888888888888888889e-3; c = c * r2 + 4.1666666666666666667e-2; c = c * r2 - 0.5; c = c * r2 + 1.0;
    const int q = (int)((long long)k & 3);
    const double cc = (q == 0) ? c : (q == 1) ? -s : (q == 2) ? -c : s;
    const double ss = (q == 0) ? s : (q == 1) ? c : (q == 2) ? -s : -c;
    co = (float)cc; si = (float)ss;
}
__device__ __forceinline__ void p0_prologue(const Args& A, LAS unsigned char* lds, int tid, int lane, int wave, int vcu, int G) {
    unsigned char* ws = A.ws;
    { LAS float* part = (LAS float*)lds;
      float* mod = (float*)(ws + WS_MOD);
      for (int it = vcu; it < 6144 / 32; it += G) {
          const int col = tid & 31, ks = tid >> 5, j = it * 32 + col; float a0 = 0.f, a1 = 0.f;
#pragma unroll 8
          for (int k = ks * 64; k < ks * 64 + 64; ++k) { const float w = A.w_ada[(size_t)k * 6144 + j]; const float c0 = A.c[k], c1 = A.c[1024 + k];
              a0 += (c0 / (1.f + __expf(-c0))) * w; a1 += (c1 / (1.f + __expf(-c1))) * w; }
          part[(0 * 16 + ks) * 32 + col] = a0; part[(1 * 16 + ks) * 32 + col] = a1;
          __syncthreads();
          if (tid < 64) { const int b = tid >> 5, cc = tid & 31; float s = A.b_ada[it * 32 + cc];
#pragma unroll
              for (int q = 0; q < 16; ++q) s += part[(b * 16 + q) * 32 + cc];
              mod[b * 6144 + it * 32 + cc] = s; }
          __syncthreads();
      } }
    { f32x2* tab = (f32x2*)(ws + WS_ROPE);
      for (int e = vcu * NTHR + tid; e < SEQ * 32; e += G * NTHR) { const int pos = e >> 5, i = e & 31; const float ang = (float)pos * A.freq[i]; float co, si; sincos_d((double)ang, co, si); tab[e] = (f32x2){co, si}; } }
    { LAS float* scr = (LAS float*)(lds + wave * 16384);
      const int gw = vcu * NWAVES + wave, NGW = G * NWAVES;
      constexpr int I_IN = (DM / 64) * (INC / 32), I_OUT = (DM / 64) * (DM / 32), I_G = (DM / 64) * (DFF / 32), I_D = (DFF / 64) * (DM / 32);
      constexpr int NITEMS = I_IN + I_OUT + 2 * I_G + I_D;
      for (int it = gw; it < NITEMS; it += NGW) {
          int r = it;
          if (r < I_IN) { p0_transpose_item(A.w_in, DM, INC, (bf16*)(ws + WS_WIN), 0, scr, r, lane); continue; } r -= I_IN;
          if (r < I_OUT) { p0_transpose_item(A.w_out, DM, DM, (bf16*)(ws + WS_WOUT), 1, scr, r, lane); continue; } r -= I_OUT;
          if (r < I_G) { p0_transpose_item(A.w_gate, DM, DFF, (bf16*)(ws + WS_WGU), 2, scr, r, lane); continue; } r -= I_G;
          if (r < I_G) { p0_transpose_item(A.w_up, DM, DFF, (bf16*)(ws + WS_WGU), 3, scr, r, lane); continue; } r -= I_G;
          p0_transpose_item(A.w_down, DFF, DM, (bf16*)(ws + WS_WD), 4, scr, r, lane);
      } }
}

__device__ __forceinline__ void p1_ln_mod(const Args& A, int lane, int gw, int NGW) {
    const float* mod = (const float*)(A.ws + WS_MOD); bf16* XN = (bf16*)(A.ws + WS_XN);
    for (int m = gw; m < M; m += NGW) {
        const int b = m / SEQ; const float* sh = mod + b * 6144, *sc = sh + 1024;
        const GAS f32x4* xr = (const GAS f32x4*)(A.x + (size_t)m * DM) + lane;
        f32x4 v[4]; float s = 0.f;
#pragma unroll
        for (int j = 0; j < 4; ++j) { v[j] = xr[64 * j]; s += (v[j].x + v[j].y) + (v[j].z + v[j].w); }
        const float mean = wave_sum(s) * (1.f / DM); float s2 = 0.f;
#pragma unroll
        for (int j = 0; j < 4; ++j) { v[j] = v[j] - mean; s2 += (v[j].x * v[j].x + v[j].y * v[j].y) + (v[j].z * v[j].z + v[j].w * v[j].w); }
        const float rstd = 1.f / sqrtf(wave_sum(s2) * (1.f / DM) + LN_EPS);
        GAS v2u* o8 = (GAS v2u*)(XN + (size_t)m * DM) + lane;
#pragma unroll
        for (int j = 0; j < 4; ++j) { const f32x4 a = *(const f32x4*)(sc + 4 * lane + 256 * j), d = *(const f32x4*)(sh + 4 * lane + 256 * j);
            const f32x4 y = v[j] * rstd * (a + 1.f) + d; o8[64 * j] = (v2u){pk2(y.x, y.y), pk2(y.z, y.w)}; }
    }
}
template <bool XN2> __device__ __forceinline__ void ln_affine_pass(const Args& A, const float* g, const float* bb, int lane, int gw, int NGW) {
    const float* mod = (const float*)(A.ws + WS_MOD); bf16* XN = (bf16*)(A.ws + WS_XN);
    for (int m = gw; m < M; m += NGW) {
        GAS f32x4* yr = (GAS f32x4*)(A.out + (size_t)m * DM) + lane;
        f32x4 v[4]; float s = 0.f;
#pragma unroll
        for (int j = 0; j < 4; ++j) { v[j] = yr[64 * j]; s += (v[j].x + v[j].y) + (v[j].z + v[j].w); }
        const float mean = wave_sum(s) * (1.f / DM); float s2 = 0.f;
#pragma unroll
        for (int j = 0; j < 4; ++j) { v[j] = v[j] - mean; s2 += (v[j].x * v[j].x + v[j].y * v[j].y) + (v[j].z * v[j].z + v[j].w * v[j].w); }
        const float rstd = 1.f / sqrtf(wave_sum(s2) * (1.f / DM) + LN_EPS);
        float t = 0.f;
#pragma unroll
        for (int j = 0; j < 4; ++j) { const f32x4 gg = *(const f32x4*)(g + 4 * lane + 256 * j), be = *(const f32x4*)(bb + 4 * lane + 256 * j);
            v[j] = v[j] * rstd * gg + be; yr[64 * j] = v[j]; t += (v[j].x + v[j].y) + (v[j].z + v[j].w); }
        if constexpr (XN2) {
            const int b = m / SEQ; const float* sh = mod + b * 6144 + 3072, *sc = sh + 1024;
            const float mean2 = wave_sum(t) * (1.f / DM); float t2 = 0.f;
#pragma unroll
            for (int j = 0; j < 4; ++j) { v[j] = v[j] - mean2; t2 += (v[j].x * v[j].x + v[j].y * v[j].y) + (v[j].z * v[j].z + v[j].w * v[j].w); }
            const float rstd2 = 1.f / sqrtf(wave_sum(t2) * (1.f / DM) + LN_EPS);
            GAS v2u* o8 = (GAS v2u*)(XN + (size_t)m * DM) + lane;
#pragma unroll
            for (int j = 0; j < 4; ++j) { const f32x4 a = *(const f32x4*)(sc + 4 * lane + 256 * j), d = *(const f32x4*)(sh + 4 * lane + 256 * j);
                const f32x4 y = v[j] * rstd2 * (a + 1.f) + d; o8[64 * j] = (v2u){pk2(y.x, y.y), pk2(y.z, y.w)}; }
        }
    }
}

struct FProj {
    bf16* P; const f32x2* tab;
    __device__ __forceinline__ void operator()(int row, int col, f32x4 v, int pn) const {
        if (pn >= 6 && pn < 10) {
            const int pos = row & (SEQ - 1), i = (col & 63) >> 1; const f32x2 c0 = tab[pos * 32 + i], c1 = tab[pos * 32 + i + 1];
            const float sc = (pn < 8) ? C2 : 1.f;
            const float a0 = (v.x * c0.x - v.y * c0.y) * sc, b0 = (v.y * c0.x + v.x * c0.y) * sc, a1 = (v.z * c1.x - v.w * c1.y) * sc, b1 = (v.w * c1.x + v.z * c1.y) * sc;
            v = (f32x4){a0, b0, a1, b1};
        }
        *(GAS v2u*)(P + (size_t)row * INC + col) = (v2u){pk2(v.x, v.y), pk2(v.z, v.w)};
    }
};
struct FRes {
    const float* R; float* Y; const float* gate;
    __device__ __forceinline__ void operator()(int row, int col, f32x4 v, int) const {
        const int b = row / SEQ; const f32x4 r = *(const GAS f32x4*)(R + (size_t)row * DM + col), g = *(const f32x4*)(gate + b * 6144 + col);
        *(GAS f32x4*)(Y + (size_t)row * DM + col) = r * ALPHA + (g + 1.f) * v;
    }
};
struct FGU {
    bf16* H;
    __device__ __forceinline__ void operator()(int row, int col, f32x4 v, int) const {
        const float h0 = v.x / (1.f + __expf(-v.x)) * v.y, h1 = v.z / (1.f + __expf(-v.z)) * v.w;
        *(GAS unsigned*)(H + (size_t)row * DFF + (col >> 1)) = pk2(h0, h1);
    }
};

__device__ __forceinline__ void na_simple(const Args& A, int gthr, int nthr) {
    const bf16* P = (const bf16*)(A.ws + WS_PROJ); bf16* CAT = (bf16*)(A.ws + WS_CAT);
    for (int it = gthr; it < M * NA_HEADS * 2; it += nthr) {
        const int m = it % M, hh = it / M, h = hh >> 1, half = hh & 1;
        const int b = m / SEQ, s = m % SEQ, r = s / GRID_W, c = s % GRID_W;
        int rs = r - NA_KR / 2; rs = rs < 0 ? 0 : (rs > ROWS - NA_KR ? ROWS - NA_KR : rs);
        int cs = c - NA_KC / 2; cs = cs < 0 ? 0 : (cs > GRID_W - NA_KC ? GRID_W - NA_KC : cs);
        float q[64];
        { const GAS v4u* qp = (const GAS v4u*)(P + (size_t)m * INC + O_NAQ + h * 64);
#pragma unroll
          for (int k = 0; k < 8; ++k) { const v4u w = qp[k]; q[8 * k] = bflo(w.x); q[8 * k + 1] = bfhi(w.x); q[8 * k + 2] = bflo(w.y); q[8 * k + 3] = bfhi(w.y); q[8 * k + 4] = bflo(w.z); q[8 * k + 5] = bfhi(w.z); q[8 * k + 6] = bflo(w.w); q[8 * k + 7] = bfhi(w.w); } }
        float o[32];
#pragma unroll
        for (int e = 0; e < 32; ++e) o[e] = 0.f;
        float mx = -1e30f, l = 0.f;
        for (int i = 0; i < NA_KR; ++i)
            for (int j = 0; j < NA_KC; ++j) {
                const size_t kt = (size_t)b * SEQ + (size_t)(rs + i) * GRID_W + (cs + j);
                const GAS v4u* kp = (const GAS v4u*)(P + kt * INC + O_NAK + h * 64);
                float d = 0.f;
#pragma unroll
                for (int k = 0; k < 8; ++k) { const v4u w = kp[k];
                    d += q[8 * k] * bflo(w.x) + q[8 * k + 1] * bfhi(w.x) + q[8 * k + 2] * bflo(w.y) + q[8 * k + 3] * bfhi(w.y) + q[8 * k + 4] * bflo(w.z) + q[8 * k + 5] * bfhi(w.z) + q[8 * k + 6] * bflo(w.w) + q[8 * k + 7] * bfhi(w.w); }
                const float sc = d * 0.125f + A.rpb[(h * 15 + (rs + i - r + NA_KR - 1)) * 31 + (cs + j - c + NA_KC - 1)];
                const float mn = fmaxf(mx, sc), al = __expf(mx - mn), p = __expf(sc - mn); mx = mn; l = l * al + p;
                const GAS v4u* vp = (const GAS v4u*)(P + kt * INC + O_NAV + h * 64 + half * 32);
#pragma unroll
                for (int k = 0; k < 4; ++k) { const v4u w = vp[k];
                    o[8 * k] = o[8 * k] * al + p * bflo(w.x); o[8 * k + 1] = o[8 * k + 1] * al + p * bfhi(w.x); o[8 * k + 2] = o[8 * k + 2] * al + p * bflo(w.y); o[8 * k + 3] = o[8 * k + 3] * al + p * bfhi(w.y);
                    o[8 * k + 4] = o[8 * k + 4] * al + p * bflo(w.z); o[8 * k + 5] = o[8 * k + 5] * al + p * bfhi(w.z); o[8 * k + 6] = o[8 * k + 6] * al + p * bflo(w.w); o[8 * k + 7] = o[8 * k + 7] * al + p * bfhi(w.w); }
            }
        const float il = 1.f / l;
        GAS v4u* op = (GAS v4u*)(CAT + (size_t)m * DM + h * 64 + half * 32);
#pragma unroll
        for (int k = 0; k < 4; ++k) op[k] = (v4u){pk2(o[8 * k] * il, o[8 * k + 1] * il), pk2(o[8 * k + 2] * il, o[8 * k + 3] * il), pk2(o[8 * k + 4] * il, o[8 * k + 5] * il), pk2(o[8 * k + 6] * il, o[8 * k + 7] * il)};
    }
}
__device__ __forceinline__ void da_simple(const Args& A, LAS unsigned char* lds, int tid, int vcu, int G) {
    const bf16* P = (const bf16*)(A.ws + WS_PROJ); float* DAO = A.out;
    LAS float* Ks = (LAS float*)lds; LAS float* Vs = (LAS float*)(lds + 16384);
    for (int it = vcu; it < 2 * 8 * 16 * 4; it += G) {
        const int quarter = it & 3, qb = (it >> 2) & 15, hm = (it >> 6) & 7, b = it >> 9, h = hm >> 1;
        const size_t m = (size_t)b * SEQ + qb * 512 + tid;
        float q[64];
        { const GAS v4u* qp = (const GAS v4u*)(P + m * INC + O_DAQ + hm * 64);
#pragma unroll
          for (int k = 0; k < 8; ++k) { const v4u w = qp[k]; q[8 * k] = bflo(w.x); q[8 * k + 1] = bfhi(w.x); q[8 * k + 2] = bflo(w.y); q[8 * k + 3] = bfhi(w.y); q[8 * k + 4] = bflo(w.z); q[8 * k + 5] = bfhi(w.z); q[8 * k + 6] = bflo(w.w); q[8 * k + 7] = bfhi(w.w); } }
        float o[32];
#pragma unroll
        for (int e = 0; e < 32; ++e) o[e] = 0.f;
        float mx = -1e30f, l = 0.f;
        for (int t = 0; t < SEQ / 64; ++t) {
            __syncthreads();
            { const int key = tid >> 3, ch = tid & 7; const v4u w = *(const GAS v4u*)(P + ((size_t)b * SEQ + t * 64 + key) * INC + O_DAK + hm * 64 + ch * 8);
              LAS f32x4* d = (LAS f32x4*)(Ks + key * 64 + ch * 8); d[0] = (f32x4){bflo(w.x), bfhi(w.x), bflo(w.y), bfhi(w.y)}; d[1] = (f32x4){bflo(w.z), bfhi(w.z), bflo(w.w), bfhi(w.w)}; }
            if (tid < 256) { const int key = tid >> 2, ch = tid & 3; const v4u w = *(const GAS v4u*)(P + ((size_t)b * SEQ + t * 64 + key) * INC + O_DAV + h * 128 + quarter * 32 + ch * 8);
              LAS f32x4* d = (LAS f32x4*)(Vs + key * 32 + ch * 8); d[0] = (f32x4){bflo(w.x), bfhi(w.x), bflo(w.y), bfhi(w.y)}; d[1] = (f32x4){bflo(w.z), bfhi(w.z), bflo(w.w), bfhi(w.w)}; }
            __syncthreads();
            for (int key = 0; key < 64; ++key) {
                const LAS f32x4* kr = (const LAS f32x4*)(Ks + key * 64); float d = 0.f;
#pragma unroll
                for (int k = 0; k < 16; ++k) { const f32x4 kk = kr[k]; d += q[4 * k] * kk.x + q[4 * k + 1] * kk.y + q[4 * k + 2] * kk.z + q[4 * k + 3] * kk.w; }
                const float mn = fmaxf(mx, d), al = __builtin_amdgcn_exp2f(mx - mn), p = __builtin_amdgcn_exp2f(d - mn); mx = mn; l = l * al + p;
                const LAS f32x4* vr = (const LAS f32x4*)(Vs + key * 32);
#pragma unroll
                for (int k = 0; k < 8; ++k) { const f32x4 vv = vr[k]; o[4 * k] = o[4 * k] * al + p * vv.x; o[4 * k + 1] = o[4 * k + 1] * al + p * vv.y; o[4 * k + 2] = o[4 * k + 2] * al + p * vv.z; o[4 * k + 3] = o[4 * k + 3] * al + p * vv.w; }
            }
        }
        const float il = 1.f / l;
        GAS f32x4* op = (GAS f32x4*)(DAO + m * DM + hm * 128 + quarter * 32);
#pragma unroll
        for (int k = 0; k < 8; ++k) op[k] = (f32x4){o[4 * k] * il, o[4 * k + 1] * il, o[4 * k + 2] * il, o[4 * k + 3] * il};
    }
}
__device__ __forceinline__ void da_combine(const Args& A, int lane, int gw, int NGW) {
    const float* DAO = A.out; bf16* CAT = (bf16*)(A.ws + WS_CAT);
    const float lam = __expf(wave_sum(A.lq1[lane] * A.lk1[lane])) - __expf(wave_sum(A.lq2[lane] * A.lk2[lane])) + LAMBDA_INIT;
    const float g0 = A.subln_g[2 * lane], g1 = A.subln_g[2 * lane + 1];
    for (int it = gw; it < M * DA_HEADS; it += NGW) {
        const int m = it >> 2, h = it & 3;
        const f32x2 a = *(const GAS f32x2*)(DAO + (size_t)m * DM + h * 256 + 2 * lane), b = *(const GAS f32x2*)(DAO + (size_t)m * DM + h * 256 + 128 + 2 * lane);
        const float o0 = a.x - lam * b.x, o1 = a.y - lam * b.y;
        const float r = 1.f / sqrtf(wave_sum(o0 * o0 + o1 * o1) * (1.f / 128.f) + LN_EPS);
        *(GAS unsigned*)(CAT + (size_t)m * DM + 512 + h * 128 + 2 * lane) = pk2(o0 * r * g0 * (1.f - LAMBDA_INIT), o1 * r * g1 * (1.f - LAMBDA_INIT));
    }
}

__global__ void __launch_bounds__(NTHR, 2) fwd_kernel(Args A) {
    extern __shared__ __attribute__((aligned(16))) unsigned char lds_raw[];
    LAS unsigned char* lds = (LAS unsigned char*)lds_raw;
    const int tid = threadIdx.x, lane = tid & 63, wave = __builtin_amdgcn_readfirstlane(tid >> 6);
    const int G = gridDim.x; const int bx = blockIdx.x; const int vcu = (G % 8 == 0) ? (bx % 8) * (G / 8) + bx / 8 : bx;
    const int gw = vcu * NWAVES + wave, NGW = G * NWAVES;
    volatile LAS unsigned* MISC = (volatile LAS unsigned*)(lds + MISC_OFF);
    for (int u = tid; u < (LDS_BYTES - LDSCTL_OFF) / 4; u += NTHR) ((LAS unsigned*)(lds + LDSCTL_OFF))[u] = 0u;
    __syncthreads();
    unsigned* barw = (unsigned*)(A.ws + WS_CTL) + CW_BAR;
    XcdBarrier bar; bar.bar = barw; bar.x = 0; bar.st = nullptr;
    const int lo = A.ph_lo, hi = A.ph_hi;
    if (hi - lo > 1) bar = xcd_barrier_post(barw, MISC + 8);
#define IN(k) (lo <= (k) && (k) < hi)
#define SEAM(k) do { if (IN(k) && IN((k) + 1)) xcd_barrier(bar); } while (0)
    unsigned char* ws = A.ws;
    const float* mod = (const float*)(ws + WS_MOD);

    if (IN(0)) { p0_prologue(A, lds, tid, lane, wave, vcu, G); }
    SEAM(0);
    if (IN(1)) { p1_ln_mod(A, lane, gw, NGW); }
    SEAM(1);
    if (IN(2)) {
        pg8::Gemm g{(const bf16*)(ws + WS_XN), (const bf16*)(ws + WS_WIN), M, INC, DM}; pg8::StaticOrder S; S.init(M, INC, G, bx);
        pg8::EpiFn<FProj> E{FProj{(bf16*)(ws + WS_PROJ), (const f32x2*)(ws + WS_ROPE)}};
        pg8::gemm_phase<pg8::EpiFn<FProj>, pg8::StaticOrder, true, true>(lds, g, S, E);
    }
    SEAM(2);
    if (IN(3)) { na_simple(A, vcu * NTHR + tid, G * NTHR); da_simple(A, lds, tid, vcu, G); }
    SEAM(3);
    if (IN(4)) { da_combine(A, lane, gw, NGW); }
    SEAM(4);
    if (IN(5)) {
        pg8::Gemm g{(const bf16*)(ws + WS_CAT), (const bf16*)(ws + WS_WOUT), M, DM, DM}; pg8::StaticOrder S; S.init(M, DM, G, bx);
        pg8::EpiFn<FRes> E{FRes{A.x, A.out, mod + 2048}};
        pg8::gemm_phase<pg8::EpiFn<FRes>, pg8::StaticOrder, true, true>(lds, g, S, E);
    }
    SEAM(5);
    if (IN(6)) { ln_affine_pass<true>(A, A.ln1_g, A.ln1_b, lane, gw, NGW); }
    SEAM(6);
    if (IN(7)) {
        pg8::Gemm g{(const bf16*)(ws + WS_XN), (const bf16*)(ws + WS_WGU), M, NGU, DM}; pg8::StaticOrder S; S.init(M, NGU, G, bx);
        pg8::EpiFn<FGU> E{FGU{(bf16*)(ws + WS_H)}};
        pg8::gemm_phase<pg8::EpiFn<FGU>, pg8::StaticOrder, true, true>(lds, g, S, E);
    }
    SEAM(7);
    if (IN(8)) {
        pg8::Gemm g{(const bf16*)(ws + WS_H), (const bf16*)(ws + WS_WD), M, DM, DFF}; pg8::StaticOrder S; S.init(M, DM, G, bx);
        pg8::EpiFn<FRes> E{FRes{A.out, A.out, mod + 5120}};
        pg8::gemm_phase<pg8::EpiFn<FRes>, pg8::StaticOrder, true, true>(lds, g, S, E);
    }
    SEAM(8);
    if (IN(9)) { ln_affine_pass<false>(A, A.ln2_g, A.ln2_b, lane, gw, NGW); }
#undef IN
#undef SEAM
}

extern "C" void kernel_launch(void* const* d_in, const int* in_sizes, int n_in, void* d_out, int out_size, void* d_ws, size_t ws_size, hipStream_t stream) {
    static int grid = 0;
    if (grid == 0) {
        if (n_in != 19 || in_sizes[0] != M * DM || out_size != M * DM || ws_size < WS_END) { fprintf(stderr, "kernel_launch: unexpected shapes (n_in %d, in0 %d, out %d, ws %zu)\n", n_in, n_in > 0 ? in_sizes[0] : -1, out_size, ws_size); grid = -1; return; }
        int dev = 0, cus = 0, per_cu = 0;
        if (hipGetDevice(&dev) != hipSuccess || hipDeviceGetAttribute(&cus, hipDeviceAttributeMultiprocessorCount, dev) != hipSuccess) { grid = -1; return; }
        if (hipFuncSetAttribute((const void*)fwd_kernel, hipFuncAttributeMaxDynamicSharedMemorySize, LDS_BYTES) != hipSuccess) { fprintf(stderr, "kernel_launch: hipFuncSetAttribute failed\n"); grid = -1; return; }
        if (hipOccupancyMaxActiveBlocksPerMultiprocessor(&per_cu, (const void*)fwd_kernel, NTHR, LDS_BYTES) != hipSuccess || per_cu < 1) { fprintf(stderr, "kernel_launch: occupancy query says %d blocks/CU\n", per_cu); (void)hipGetLastError(); grid = -1; return; }
        grid = cus;
    }
    if (grid < 0) return;
    Args a{};
    a.x = (const float*)d_in[0]; a.c = (const float*)d_in[1]; a.w_ada = (const float*)d_in[2]; a.b_ada = (const float*)d_in[3]; a.w_in = (const float*)d_in[4]; a.rpb = (const float*)d_in[5];
    a.lq1 = (const float*)d_in[6]; a.lk1 = (const float*)d_in[7]; a.lq2 = (const float*)d_in[8]; a.lk2 = (const float*)d_in[9]; a.subln_g = (const float*)d_in[10]; a.w_out = (const float*)d_in[11];
    a.ln1_g = (const float*)d_in[12]; a.ln1_b = (const float*)d_in[13]; a.w_gate = (const float*)d_in[14]; a.w_up = (const float*)d_in[15]; a.w_down = (const float*)d_in[16]; a.ln2_g = (const float*)d_in[17]; a.ln2_b = (const float*)d_in[18];
    a.out = (float*)d_out; a.ws = (unsigned char*)d_ws;
    for (int i = 0; i < 32; ++i) a.freq[i] = 1.0f / powf(10000.0f, (float)i / 32.0f);
    if (MK_N_LAUNCHES == 1) {
        if (hipMemsetAsync((char*)d_ws + WS_CTL, 0, CTL_ZERO_BYTES, stream) != hipSuccess) return;
        a.ph_lo = 0; a.ph_hi = N_PHASES;
        hipLaunchKernelGGL(fwd_kernel, dim3(grid), dim3(NTHR), LDS_BYTES, stream, a);
    } else {
        for (int p = 0; p < N_PHASES; ++p) { a.ph_lo = p; a.ph_hi = p + 1; hipLaunchKernelGGL(fwd_kernel, dim3(grid), dim3(NTHR), LDS_BYTES, stream, a); }
    }
    const hipError_t le = hipPeekAtLastError();
    if (le != hipSuccess) fprintf(stderr, "kernel_launch: launch failed: %s\n", hipGetErrorName(le));
}
```

```cpp
#include <hip/hip_runtime.h>
#include <cstdio>
#include <cstdint>
#include <cmath>

#ifndef MK_N_LAUNCHES
#define MK_N_LAUNCHES 1
#endif

constexpr int BATCH = 2, SEQ = 8192, DM = 1024, M = BATCH * SEQ;
constexpr int GRID_W = 64, NA_HEADS = 8, HD = 64, NA_KR = 8, NA_KC = 16, ROWS = SEQ / GRID_W;
constexpr int DA_HEADS = 4, DA_V = 128;
constexpr int INC = 3072, DFF = 2816, NGU = 2 * DFF;
constexpr int O_NAQ = 0, O_NAK = 512, O_NAV = 1024, O_DAQ = 1536, O_DAK = 2048, O_DAV = 2560;
constexpr float LN_EPS = 1e-5f;
constexpr float ALPHA = 1.189207115002721f;
constexpr float LAMBDA_INIT = 0.2f;
constexpr float C2 = 0.125f * 1.4426950408889634f;

namespace pg8 {
#define PG8_LAS __attribute__((address_space(3)))
typedef unsigned short bf16_t;
typedef short bf16x8 __attribute__((ext_vector_type(8)));
typedef float f32x4 __attribute__((ext_vector_type(4)));
typedef unsigned u32x4 __attribute__((ext_vector_type(4)));
constexpr int BM = 256, BK = 64, HALF = 128, HTB = HALF * BK * 2, STAGE_BYTES = 8 * HTB, NXCD = 8, WGM = 8;

__host__ __device__ __forceinline__ int lds_byte(int r, int c) { const int st = (r >> 4) * 2 + (c >> 5), rr = r & 15, cc = c & 31, ob = rr * 64 + cc * 2; return st * 1024 + (ob ^ (((ob >> 9) & 1) << 5)); }
__host__ __device__ __forceinline__ void stage_rc(int b, int& R, int& C) { const int st = b / 1024, sb = b % 1024, swz = sb ^ (((sb >> 9) & 1) << 5); R = (st >> 1) * 16 + swz / 64; C = (st & 1) * 32 + (swz % 64) / 2; }
__host__ __device__ __forceinline__ int perm32(int rho) { const int n = rho >> 4, i = rho & 15; return 8 * (i >> 2) + 4 * n + (i & 3); }

struct Unit { int pm, pn; };
struct Gemm { const bf16_t* A; const bf16_t* Bt; int M, N, K; };

struct StaticOrder {
    int nM, nN, nwg, G, c;
    __host__ __device__ void init(int M_, int N_, int G_, int c_) { nM = M_ / BM; nN = N_ / BM; nwg = nM * nN; G = G_; c = c_; }
    __host__ __device__ bool next(int i, Unit& u) const {
        const long L = (long)i * G + c; if (L >= nwg) return false;
        int wgid = (int)L; { const int q = nwg / NXCD, r = nwg % NXCD, xcd = wgid % NXCD, off = wgid / NXCD; wgid = (xcd < r ? xcd * (q + 1) : r * (q + 1) + (xcd - r) * q) + off; }
        const int nig = WGM * nN, gid = wgid / nig, fm = gid * WGM, gsz = (nM - fm) < WGM ? (nM - fm) : WGM;
        u.pm = fm + ((wgid % nig) % gsz); u.pn = (wgid % nig) / gsz; return true;
    }
    __device__ __forceinline__ void a_ready(const Unit&) const {}
    __device__ __forceinline__ void done(const Unit&) const {}
};

template <class F> struct EpiFn {
    static constexpr bool PERM = false, AFTER_DRAIN = false; F f;
    __device__ __forceinline__ void operator()(const f32x4 (&acc)[2][2][4][2], const Unit& u, int wr, int wc, int fr, int fq) const {
#pragma unroll
        for (int ai = 0; ai < 2; ++ai)
#pragma unroll
            for (int m = 0; m < 4; ++m) { const int row = u.pm * BM + ai * HALF + wr * 64 + m * 16 + fr;
#pragma unroll
                for (int bj = 0; bj < 2; ++bj)
#pragma unroll
                    for (int n = 0; n < 2; ++n) f(row, u.pn * BM + bj * HALF + wc * 32 + n * 16 + 4 * fq, acc[ai][bj][m][n], u.pn); }
    }
    __device__ __forceinline__ void fused(f32x4 (&)[2][2][4][2], const Unit&, int, int, int, int, PG8_LAS unsigned char*, int, int) const {}
};

template <class Epi, class Sched, bool ALIGN_EPI = false, bool SP2 = false>
__device__ __forceinline__ void gemm_phase(PG8_LAS unsigned char* lds, const Gemm g, const Sched& S, const Epi& E) {
    const int tid = threadIdx.x, wid = __builtin_amdgcn_readfirstlane(tid >> 6), lane = tid & 63, wr = wid >> 2, wc = wid & 3, fr = lane & 15, fq = lane >> 4;
    const int K = g.K, nt = K / BK;
    unsigned voffA[2], voffB[2];
#pragma unroll
    for (int i = 0; i < 2; ++i) { int R, C; stage_rc(tid * 16 + i * 8192, R, C); const int Rb = Epi::PERM ? ((R & ~31) + perm32(R & 31)) : R;
        voffA[i] = (unsigned)(R * K + C) * 2u; voffB[i] = (unsigned)(Rb * K + C) * 2u; }
    const size_t kstep = (size_t)(BK * 2);
    const size_t hstep = (size_t)HALF * K * 2;
    const size_t tstep = 2 * hstep;
    const unsigned ldsw = (unsigned)wid * 1024u;
    const int aoff = lds_byte(wr * 64 + fr, fq * 8), boff = lds_byte(wc * 32 + fr, fq * 8);
#define PG8_SA(b, h) (((b) * 2 + (h)) * HTB)
#define PG8_SB(b, h) ((4 + (b) * 2 + (h)) * HTB)
#define PG8_STAGE(bufoff, gbase, voff) do { _Pragma("unroll") for (int _i = 0; _i < 2; ++_i) \
        __builtin_amdgcn_global_load_lds((const unsigned*)((const char*)(gbase) + (voff)[_i]), (PG8_LAS unsigned*)(lds + (bufoff) + ldsw + _i * 8192), 16, 0, 0); } while (0)
#define PG8_LDA(dst, b, h) do { _Pragma("unroll") for (int m = 0; m < 4; ++m) _Pragma("unroll") for (int k = 0; k < 2; ++k) dst[m][k] = *(const PG8_LAS bf16x8*)(lds + PG8_SA(b, h) + aoff + m * 2048 + k * 1024); } while (0)
#define PG8_LDB(dst, b, h) do { _Pragma("unroll") for (int n = 0; n < 2; ++n) _Pragma("unroll") for (int k = 0; k < 2; ++k) dst[n][k] = *(const PG8_LAS bf16x8*)(lds + PG8_SB(b, h) + boff + n * 2048 + k * 1024); } while (0)
#define PG8_MMA(ai, bj, At, Bt) do { __builtin_amdgcn_s_setprio(1); _Pragma("unroll") for (int m = 0; m < 4; ++m) _Pragma("unroll") for (int n = 0; n < 2; ++n) _Pragma("unroll") for (int k = 0; k < 2; ++k) \
        acc[ai][bj][m][n] = __builtin_amdgcn_mfma_f32_16x16x32_bf16(Bt[n][k], At[m][k], acc[ai][bj][m][n], 0, 0, 0); __builtin_amdgcn_s_setprio(0); } while (0)
#define PG8_WAIT_V(n) asm volatile("s_waitcnt vmcnt(" #n ")" ::: "memory")
#define PG8_WAIT_L(n) asm volatile("s_waitcnt lgkmcnt(" #n ")" ::: "memory")
#define PG8_BAR __builtin_amdgcn_s_barrier()
#define PG8_SCHED __builtin_amdgcn_sched_barrier(0)
    Unit cur, nxt; int ui = 0;
    if (!S.next(0, cur)) return;
    f32x4 acc[2][2][4][2];
#pragma unroll
    for (int a = 0; a < 2; ++a)
#pragma unroll
        for (int b = 0; b < 2; ++b)
#pragma unroll
            for (int m = 0; m < 4; ++m)
#pragma unroll
                for (int n = 0; n < 2; ++n) acc[a][b][m][n] = (f32x4){0.f, 0.f, 0.f, 0.f};
    bf16x8 At[4][2], B0[2][2], B1[2][2];
    const char* cA = (const char*)g.A + (size_t)cur.pm * tstep; const char* cB = (const char*)g.Bt + (size_t)cur.pn * tstep;
    S.a_ready(cur);
    if constexpr (SP2) {
        PG8_STAGE(PG8_SB(0, 0), cB, voffB); PG8_STAGE(PG8_SB(0, 1), cB + hstep, voffB); PG8_STAGE(PG8_SA(0, 0), cA, voffA); PG8_STAGE(PG8_SA(0, 1), cA + hstep, voffA);
        if (wr == 1) PG8_BAR;
        PG8_WAIT_V(2); PG8_BAR;
        PG8_STAGE(PG8_SB(1, 0), cB + kstep, voffB); PG8_STAGE(PG8_SA(1, 0), cA + kstep, voffA); PG8_STAGE(PG8_SB(1, 1), cB + hstep + kstep, voffB);
        PG8_WAIT_V(6); PG8_BAR;
    } else {
        PG8_STAGE(PG8_SB(0, 0), cB, voffB); PG8_STAGE(PG8_SA(0, 0), cA, voffA); PG8_STAGE(PG8_SB(0, 1), cB + hstep, voffB); PG8_STAGE(PG8_SA(0, 1), cA + hstep, voffA);
        if (wr == 1) PG8_BAR;
        PG8_WAIT_V(4); PG8_BAR;
        PG8_STAGE(PG8_SB(1, 0), cB + kstep, voffB); PG8_STAGE(PG8_SA(1, 0), cA + kstep, voffA); PG8_STAGE(PG8_SB(1, 1), cB + hstep + kstep, voffB);
        PG8_WAIT_V(6); PG8_BAR;
    }
    for (;;) {
        const bool has_next = S.next(ui + 1, nxt);
        const char* nA = has_next ? (const char*)g.A + (size_t)nxt.pm * tstep : cA; const char* nB = has_next ? (const char*)g.Bt + (size_t)nxt.pn * tstep : cB;
        for (int t = 0; t < nt; t += 2) {
            const bool last = (t == nt - 2);
            const char* a1 = cA + (size_t)(t + 1) * kstep;
            const char* a2 = last ? nA : cA + (size_t)(t + 2) * kstep; const char* b2 = last ? nB : cB + (size_t)(t + 2) * kstep;
            const char* a3 = a2 + kstep; const char* b3 = b2 + kstep;
            if (last && has_next) S.a_ready(nxt);
            if constexpr (SP2) {
            PG8_LDB(B0, 0, 0); PG8_LDB(B1, 0, 1); PG8_SCHED; PG8_LDA(At, 0, 0); PG8_STAGE(PG8_SA(1, 1), a1 + hstep, voffA);
            PG8_WAIT_V(8); PG8_WAIT_L(0); PG8_BAR; PG8_MMA(0, 0, At, B0); PG8_MMA(0, 1, At, B1); PG8_BAR; PG8_SCHED;
            PG8_LDA(At, 0, 1); PG8_STAGE(PG8_SB(0, 0), b2, voffB); PG8_STAGE(PG8_SB(0, 1), b2 + hstep, voffB); PG8_STAGE(PG8_SA(0, 0), a2, voffA);
            PG8_WAIT_V(8); PG8_WAIT_L(0); PG8_BAR; PG8_MMA(1, 0, At, B0); PG8_MMA(1, 1, At, B1); PG8_BAR; PG8_SCHED;
            PG8_LDB(B0, 1, 0); PG8_LDB(B1, 1, 1); PG8_SCHED; PG8_LDA(At, 1, 0); PG8_STAGE(PG8_SA(0, 1), a2 + hstep, voffA);
            PG8_WAIT_V(8); PG8_WAIT_L(0); PG8_BAR; PG8_MMA(0, 0, At, B0); PG8_MMA(0, 1, At, B1); PG8_BAR; PG8_SCHED;
            PG8_LDA(At, 1, 1); PG8_STAGE(PG8_SB(1, 0), b3, voffB); PG8_STAGE(PG8_SB(1, 1), b3 + hstep, voffB); PG8_STAGE(PG8_SA(1, 0), a3, voffA);
            PG8_WAIT_V(8); PG8_WAIT_L(0); PG8_BAR; PG8_MMA(1, 0, At, B0); PG8_MMA(1, 1, At, B1); PG8_BAR; PG8_SCHED;
            } else {
            PG8_LDB(B0, 0, 0); PG8_SCHED; PG8_LDA(At, 0, 0); PG8_STAGE(PG8_SA(1, 1), a1 + hstep, voffA);
            PG8_WAIT_L(8); PG8_BAR; PG8_WAIT_L(0); PG8_MMA(0, 0, At, B0); PG8_BAR; PG8_SCHED;
            PG8_LDB(B1, 0, 1); PG8_STAGE(PG8_SB(0, 0), b2, voffB);
            PG8_BAR; PG8_WAIT_L(0); PG8_MMA(0, 1, At, B1); PG8_BAR;
            PG8_LDA(At, 0, 1); PG8_STAGE(PG8_SA(0, 0), a2, voffA);
            PG8_BAR; PG8_WAIT_L(0); PG8_MMA(1, 0, At, B0); PG8_BAR; PG8_SCHED;
            PG8_STAGE(PG8_SB(0, 1), b2 + hstep, voffB);
            PG8_WAIT_V(6); PG8_BAR; PG8_MMA(1, 1, At, B1); PG8_BAR;
            PG8_LDB(B0, 1, 0); PG8_SCHED; PG8_LDA(At, 1, 0); PG8_STAGE(PG8_SA(0, 1), a2 + hstep, voffA);
            PG8_WAIT_L(8); PG8_BAR; PG8_WAIT_L(0); PG8_MMA(0, 0, At, B0); PG8_BAR; PG8_SCHED;
            PG8_LDB(B1, 1, 1); PG8_STAGE(PG8_SB(1, 0), b3, voffB);
            PG8_BAR; PG8_WAIT_L(0); PG8_MMA(0, 1, At, B1); PG8_BAR;
            PG8_LDA(At, 1, 1); PG8_STAGE(PG8_SA(1, 0), a3, voffA);
            PG8_BAR; PG8_WAIT_L(0); PG8_MMA(1, 0, At, B0); PG8_BAR; PG8_SCHED;
            PG8_STAGE(PG8_SB(1, 1), b3 + hstep, voffB);
            PG8_WAIT_V(6); PG8_BAR; PG8_MMA(1, 1, At, B1); PG8_BAR;
            }
        }
        if constexpr (ALIGN_EPI) { if (wr == 0) PG8_BAR; }
        if constexpr (!Epi::AFTER_DRAIN) { E(acc, cur, wr, wc, fr, fq); S.done(cur); }
        if (!has_next) break;
#pragma unroll
        for (int a = 0; a < 2; ++a)
#pragma unroll
            for (int b = 0; b < 2; ++b)
#pragma unroll
                for (int m = 0; m < 4; ++m)
#pragma unroll
                    for (int n = 0; n < 2; ++n) acc[a][b][m][n] = (f32x4){0.f, 0.f, 0.f, 0.f};
        cur = nxt; cA = nA; cB = nB; ++ui;
        if constexpr (ALIGN_EPI) { if (wr == 1) PG8_BAR; }
    }
    PG8_WAIT_V(0);
    if constexpr (!ALIGN_EPI) { if (wr == 0) PG8_BAR; }
    PG8_BAR;
    if constexpr (Epi::AFTER_DRAIN) { E.fused(acc, cur, wr, wc, fr, fq, lds, wid, lane); S.done(cur); }
#undef PG8_SA
#undef PG8_SB
#undef PG8_STAGE
#undef PG8_LDA
#undef PG8_LDB
#undef PG8_MMA
#undef PG8_WAIT_V
#undef PG8_WAIT_L
#undef PG8_BAR
#undef PG8_SCHED
}
}

constexpr int NWAVES = 8, NTHR = NWAVES * 64;
constexpr int N_PHASES = 10;
constexpr size_t MiB = 1u << 20;
constexpr size_t WS_CTL = 0, CTL_ZERO_BYTES = 64 * 1024;
constexpr size_t WS_MOD = 1 * MiB;
constexpr size_t WS_ROPE = 2 * MiB;
constexpr size_t WS_WIN = 4 * MiB;
constexpr size_t WS_WOUT = 10 * MiB;
constexpr size_t WS_WGU = 12 * MiB;
constexpr size_t WS_WD = 23 * MiB;
constexpr size_t WS_XN = 32 * MiB;
constexpr size_t WS_PROJ = 64 * MiB;
constexpr size_t WS_H = WS_PROJ;
constexpr size_t WS_CAT = 160 * MiB;
constexpr size_t WS_END = 192 * MiB;
constexpr int CW_BAR = 1024;
constexpr int RING_BYTES = 131072, LDSCTL_OFF = RING_BYTES, MISC_OFF = LDSCTL_OFF + 320, LDS_BYTES = 147456;

#define GAS __attribute__((address_space(1)))
#define LAS __attribute__((address_space(3)))
typedef unsigned short bf16;
typedef unsigned v4u __attribute__((ext_vector_type(4)));
typedef unsigned v2u __attribute__((ext_vector_type(2)));
typedef float f32x4 __attribute__((ext_vector_type(4)));
typedef float f32x2 __attribute__((ext_vector_type(2)));
#define LDS_WAIT() asm volatile("s_waitcnt lgkmcnt(0)" ::: "memory")
#define VM_WAIT() asm volatile("s_waitcnt vmcnt(0)" ::: "memory")
__device__ __forceinline__ unsigned f2bf(float f) { unsigned u = __builtin_bit_cast(unsigned, f); return (u + 0x7fffu + ((u >> 16) & 1u)) >> 16; }
__device__ __forceinline__ unsigned pk2(float lo, float hi) { return f2bf(lo) | (f2bf(hi) << 16); }
__device__ __forceinline__ float bflo(unsigned w) { return __builtin_bit_cast(float, w << 16); }
__device__ __forceinline__ float bfhi(unsigned w) { return __builtin_bit_cast(float, w & 0xffff0000u); }
__device__ __forceinline__ float wave_sum(float v) {
#pragma unroll
    for (int o = 1; o < 64; o <<= 1) v += __shfl_xor(v, o);
    return v;
}

#define XB_TMO      128
#define XB_XCNT(j)  (256  + 64 * (j))
#define XB_XSUB(j)  (1280 + 64 * (j))
#define XB_XGEN(j)  (2304 + 64 * (j))
#define XB_TOP      3328
#define XB_TOPGEN   3392
#define XCD_BAR_WORDS 3456
#define XB_SPIN_CAP (1u << 18)
__device__ __forceinline__ unsigned xb_ld(unsigned* p)              { return __hip_atomic_load(p, __ATOMIC_RELAXED, __HIP_MEMORY_SCOPE_AGENT); }
__device__ __forceinline__ unsigned xb_add(unsigned* p, unsigned v) { return __hip_atomic_fetch_add(p, v, __ATOMIC_RELAXED, __HIP_MEMORY_SCOPE_AGENT); }
__device__ __forceinline__ unsigned xb_xcc_id() { return (unsigned)__builtin_amdgcn_s_getreg((3 << 11) | 20) & 0xFu; }
#define XB_SPIN(cond, bar) do { unsigned _sp = 0; while (cond) { __builtin_amdgcn_s_sleep(1); \
    if ((++_sp & 255u) == 0u) { if (xb_ld(&(bar)[XB_TMO])) break; if (_sp > XB_SPIN_CAP) { atomicAdd(&(bar)[XB_TMO], 1u); break; } } } } while (0)
struct XcdBarrier { unsigned* bar; unsigned x; volatile LAS unsigned* st; };
__device__ __forceinline__ XcdBarrier xcd_barrier_post(unsigned* bar, volatile LAS unsigned* st) {
    XcdBarrier b; b.bar = bar; b.x = xb_xcc_id(); b.st = st;
    if (threadIdx.x == 0) (void)xb_add(&bar[XB_XCNT(b.x)], 1u);
    return b;
}
__device__ __forceinline__ void xcd_barrier_complete(unsigned* bar, unsigned x, unsigned& nloc, unsigned& nx) {
    const unsigned G = gridDim.x * gridDim.y * gridDim.z;
    unsigned sum, cnt, mine, sp = 0u;
    for (;;) {
        sum = 0u; cnt = 0u; mine = 0u;
#pragma unroll
        for (unsigned j = 0; j < 16; ++j) { const unsigned c = xb_ld(&bar[XB_XCNT(j)]); sum += c; cnt += (c > 0u) ? 1u : 0u; mine = (j == x) ? c : mine; }
        if (sum == G) break;
        __builtin_amdgcn_s_sleep(1);
        if ((++sp & 255u) == 0u) { if (xb_ld(&bar[XB_TMO])) break; if (sp > XB_SPIN_CAP) { atomicAdd(&bar[XB_TMO], 1u); break; } }
    }
    nloc = mine > 0u ? mine : 1u; nx = cnt > 0u ? cnt : 1u;
}
__device__ __forceinline__ void xcd_barrier(const XcdBarrier& b) {
    asm volatile("s_waitcnt vmcnt(0)" ::: "memory");
    __syncthreads();
    if (threadIdx.x == 0) {
        unsigned* bar = b.bar;
        __builtin_amdgcn_s_waitcnt(0);
        unsigned nloc = b.st[0], nx = b.st[1];
        if (nloc == 0u) { xcd_barrier_complete(bar, b.x, nloc, nx); b.st[0] = nloc; b.st[1] = nx; }
        const unsigned old = xb_add(&bar[XB_XSUB(b.x)], 1u);
        const unsigned gen = old / nloc;
        if (old + 1u == (gen + 1u) * nloc) {
            __builtin_amdgcn_fence(__ATOMIC_RELEASE, "agent");
            asm volatile("s_waitcnt vmcnt(0)" ::: "memory");
            const unsigned og = xb_add(&bar[XB_TOP], 1u);
            const unsigned tg = og / nx;
            if (og + 1u == (tg + 1u) * nx) xb_add(&bar[XB_TOPGEN], 1u);
            else XB_SPIN(xb_ld(&bar[XB_TOPGEN]) == tg, bar);
            __builtin_amdgcn_fence(__ATOMIC_ACQUIRE, "agent");
            xb_add(&bar[XB_XGEN(b.x)], 1u);
            asm volatile("s_waitcnt vmcnt(0)" ::: "memory");
        } else {
            XB_SPIN(xb_ld(&bar[XB_XGEN(b.x)]) == gen, bar);
            __builtin_amdgcn_fence(__ATOMIC_ACQUIRE, "agent");
            asm volatile("s_waitcnt vmcnt(0)" ::: "memory");
        }
    }
    __syncthreads();
}

struct Args {
    const float* x; const float* c; const float* w_ada; const float* b_ada; const float* w_in; const float* rpb;
    const float* lq1; const float* lk1; const float* lq2; const float* lk2; const float* subln_g; const float* w_out;
    const float* ln1_g; const float* ln1_b; const float* w_gate; const float* w_up; const float* w_down; const float* ln2_g; const float* ln2_b;
    float* out; unsigned char* ws; int ph_lo, ph_hi; float freq[32];
};

__device__ __forceinline__ int dst_row(int mat, int n) {
    if (mat == 0) { if (n < O_DAQ || n >= O_DAV) return n; const int d = n & 63; return (n & ~63) + (d < 32 ? 2 * d : 2 * (d - 32) + 1); }
    if (mat == 2) return 2 * n;
    if (mat == 3) return 2 * n + 1;
    return n;
}
__device__ __forceinline__ void p0_transpose_item(const float* W, int K, int N, bf16* WT, int mat, LAS float* scr, int item, int lane) {
    const int nblk = N / 32, kb = item / nblk, nb = item % nblk, k0 = 64 * kb, n0 = 32 * nb;
#pragma unroll 8
    for (int i = 0; i < 32; ++i) { const int kk = 2 * i + (lane >> 5); scr[kk * 33 + (lane & 31)] = W[(size_t)(k0 + kk) * N + n0 + (lane & 31)]; }
    LDS_WAIT(); asm volatile("" ::: "memory");
    const int c = lane & 7;
#pragma unroll
    for (int j = 0; j < 4; ++j) { const int n = (lane >> 3) + 8 * j; const LAS float* s = scr + (8 * c) * 33 + n;
        v4u o; o.x = pk2(s[0 * 33], s[1 * 33]); o.y = pk2(s[2 * 33], s[3 * 33]); o.z = pk2(s[4 * 33], s[5 * 33]); o.w = pk2(s[6 * 33], s[7 * 33]);
        *(GAS v4u*)(WT + (size_t)dst_row(mat, n0 + n) * K + k0 + 8 * c) = o; }
    LDS_WAIT(); asm volatile("" ::: "memory");
}
__device__ __forceinline__ void sincos_d(double a, float& co, float& si) {
    const double k = __builtin_rint(a * 0.63661977236758134308);
    const double r = __builtin_fma(-k, 1.57079632679489661923, a) - k * 6.123233995736766e-17;
    const double r2 = r * r;
    double s = -2.5052108385441718775e-8; s = s * r2 + 2.7557319223985890653e-6; s = s * r2 - 1.9841269841269841270e-4; s = s * r2 + 8.3333333333333333333e-3; s = s * r2 - 1.6666666666666666667e-1; s = s * r2 * r + r;
    double c = 2.0876756987868098979e-9; c = c * r2 - 2.7557319223985890653e-7; c = c * r2 + 2.4801587301587301587e-5; c = c * r2 - 1.3888888888888888889e-3; c = c * r2 + 4.1666666666666666667e-2; c = c * r2 - 0.5; c = c * r2 + 1.0;
    const int q = (int)((long long)k & 3);
    const double cc = (q == 0) ? c : (q == 1) ? -s : (q == 2) ? -c : s;
    const double ss = (q == 0) ? s : (q == 1) ? c : (q == 2) ? -s : -c;
    co = (float)cc; si = (float)ss;
}
__device__ __forceinline__ void p0_prologue(const Args& A, LAS unsigned char* lds, int tid, int lane, int wave, int vcu, int G) {
    unsigned char* ws = A.ws;
    { LAS float* part = (LAS float*)lds;
      float* mod = (float*)(ws + WS_MOD);
      for (int it = vcu; it < 6144 / 32; it += G) {
          const int col = tid & 31, ks = tid >> 5, j = it * 32 + col; float a0 = 0.f, a1 = 0.f;
#pragma unroll 8
          for (int k = ks * 64; k < ks * 64 + 64; ++k) { const float w = A.w_ada[(size_t)k * 6144 + j]; const float c0 = A.c[k], c1 = A.c[1024 + k];
              a0 += (c0 / (1.f + __expf(-c0))) * w; a1 += (c1 / (1.f + __expf(-c1))) * w; }
          part[(0 * 16 + ks) * 32 + col] = a0; part[(1 * 16 + ks) * 32 + col] = a1;
          __syncthreads();
          if (tid < 64) { const int b = tid >> 5, cc = tid & 31; float s = A.b_ada[it * 32 + cc];
#pragma unroll
              for (int q = 0; q < 16; ++q) s += part[(b * 16 + q) * 32 + cc];
              mod[b * 6144 + it * 32 + cc] = s; }
          __syncthreads();
      } }
    { f32x2* tab = (f32x2*)(ws + WS_ROPE);
      for (int e = vcu * NTHR + tid; e < SEQ * 32; e += G * NTHR) { const int pos = e >> 5, i = e & 31; const float ang = (float)pos * A.freq[i]; float co, si; sincos_d((double)ang, co, si); tab[e] = (f32x2){co, si}; } }
    { LAS float* scr = (LAS float*)(lds + wave * 16384);
      const int gw = vcu * NWAVES + wave, NGW = G * NWAVES;
      constexpr int I_IN = (DM / 64) * (INC / 32), I_OUT = (DM / 64) * (DM / 32), I_G = (DM / 64) * (DFF / 32), I_D = (DFF / 64) * (DM / 32);
      constexpr int NITEMS = I_IN + I_OUT + 2 * I_G + I_D;
      for (int it = gw; it < NITEMS; it += NGW) {
          int r = it;
          if (r < I_IN) { p0_transpose_item(A.w_in, DM, INC, (bf16*)(ws + WS_WIN), 0, scr, r, lane); continue; } r -= I_IN;
          if (r < I_OUT) { p0_transpose_item(A.w_out, DM, DM, (bf16*)(ws + WS_WOUT), 1, scr, r, lane); continue; } r -= I_OUT;
          if (r < I_G) { p0_transpose_item(A.w_gate, DM, DFF, (bf16*)(ws + WS_WGU), 2, scr, r, lane); continue; } r -= I_G;
          if (r < I_G) { p0_transpose_item(A.w_up, DM, DFF, (bf16*)(ws + WS_WGU), 3, scr, r, lane); continue; } r -= I_G;
          p0_transpose_item(A.w_down, DFF, DM, (bf16*)(ws + WS_WD), 4, scr, r, lane);
      } }
}

__device__ __forceinline__ void p1_ln_mod(const Args& A, int lane, int gw, int NGW) {
    const float* mod = (const float*)(A.ws + WS_MOD); bf16* XN = (bf16*)(A.ws + WS_XN);
    for (int m = gw; m < M; m += NGW) {
        const int b = m / SEQ; const float* sh = mod + b * 6144, *sc = sh + 1024;
        const GAS f32x4* xr = (const GAS f32x4*)(A.x + (size_t)m * DM) + lane;
        f32x4 v[4]; float s = 0.f;
#pragma unroll
        for (int j = 0; j < 4; ++j) { v[j] = xr[64 * j]; s += (v[j].x + v[j].y) + (v[j].z + v[j].w); }
        const float mean = wave_sum(s) * (1.f / DM); float s2 = 0.f;
#pragma unroll
        for (int j = 0; j < 4; ++j) { v[j] = v[j] - mean; s2 += (v[j].x * v[j].x + v[j].y * v[j].y) + (v[j].z * v[j].z + v[j].w * v[j].w); }
        const float rstd = 1.f / sqrtf(wave_sum(s2) * (1.f / DM) + LN_EPS);
        GAS v2u* o8 = (GAS v2u*)(XN + (size_t)m * DM) + lane;
#pragma unroll
        for (int j = 0; j < 4; ++j) { const f32x4 a = *(const f32x4*)(sc + 4 * lane + 256 * j), d = *(const f32x4*)(sh + 4 * lane + 256 * j);
            const f32x4 y = v[j] * rstd * (a + 1.f) + d; o8[64 * j] = (v2u){pk2(y.x, y.y), pk2(y.z, y.w)}; }
    }
}
template <bool XN2> __device__ __forceinline__ void ln_affine_pass(const Args& A, const float* g, const float* bb, int lane, int gw, int NGW) {
    const float* mod = (const float*)(A.ws + WS_MOD); bf16* XN = (bf16*)(A.ws + WS_XN);
    for (int m = gw; m < M; m += NGW) {
        GAS f32x4* yr = (GAS f32x4*)(A.out + (size_t)m * DM) + lane;
        f32x4 v[4]; float s = 0.f;
#pragma unroll
        for (int j = 0; j < 4; ++j) { v[j] = yr[64 * j]; s += (v[j].x + v[j].y) + (v[j].z + v[j].w); }
        const float mean = wave_sum(s) * (1.f / DM); float s2 = 0.f;
#pragma unroll
        for (int j = 0; j < 4; ++j) { v[j] = v[j] - mean; s2 += (v[j].x * v[j].x + v[j].y * v[j].y) + (v[j].z * v[j].z + v[j].w * v[j].w); }
        const float rstd = 1.f / sqrtf(wave_sum(s2) * (1.f / DM) + LN_EPS);
        float t = 0.f;
#pragma unroll
        for (int j = 0; j < 4; ++j) { const f32x4 gg = *(const f32x4*)(g + 4 * lane + 256 * j), be = *(const f32x4*)(bb + 4 * lane + 256 * j);
            v[j] = v[j] * rstd * gg + be; yr[64 * j] = v[j]; t += (v[j].x + v[j].y) + (v[j].z + v[j].w); }
        if constexpr (XN2) {
            const int b = m / SEQ; const float* sh = mod + b * 6144 + 3072, *sc = sh + 1024;
            const float mean2 = wave_sum(t) * (1.f / DM); float t2 = 0.f;
#pragma unroll
            for (int j = 0; j < 4; ++j) { v[j] = v[j] - mean2; t2 += (v[j].x * v[j].x + v[j].y * v[j].y) + (v[j].z * v[j].z + v[j].w * v[j].w); }
            const float rstd2 = 1.f / sqrtf(wave_sum(t2) * (1.f / DM) + LN_EPS);
            GAS v2u* o8 = (GAS v2u*)(XN + (size_t)m * DM) + lane;
#pragma unroll
            for (int j = 0; j < 4; ++j) { const f32x4 a = *(const f32x4*)(sc + 4 * lane + 256 * j), d = *(const f32x4*)(sh + 4 * lane + 256 * j);
                const f32x4 y = v[j] * rstd2 * (a + 1.f) + d; o8[64 * j] = (v2u){pk2(y.x, y.y), pk2(y.z, y.w)}; }
        }
    }
}

struct FProj {
    bf16* P; const f32x2* tab;
    __device__ __forceinline__ void operator()(int row, int col, f32x4 v, int pn) const {
        if (pn >= 6 && pn < 10) {
            const int pos = row & (SEQ - 1), i = (col & 63) >> 1; const f32x2 c0 = tab[pos * 32 + i], c1 = tab[pos * 32 + i + 1];
            const float sc = (pn < 8) ? C2 : 1.f;
            const float a0 = (v.x * c0.x - v.y * c0.y) * sc, b0 = (v.y * c0.x + v.x * c0.y) * sc, a1 = (v.z * c1.x - v.w * c1.y) * sc, b1 = (v.w * c1.x + v.z * c1.y) * sc;
            v = (f32x4){a0, b0, a1, b1};
        }
        *(GAS v2u*)(P + (size_t)row * INC + col) = (v2u){pk2(v.x, v.y), pk2(v.z, v.w)};
    }
};
struct FRes {
    const float* R; float* Y; const float* gate;
    __device__ __forceinline__ void operator()(int row, int col, f32x4 v, int) const {
        const int b = row / SEQ; const f32x4 r = *(const GAS f32x4*)(R + (size_t)row * DM + col), g = *(const f32x4*)(gate + b * 6144 + col);
        *(GAS f32x4*)(Y + (size_t)row * DM + col) = r * ALPHA + (g + 1.f) * v;
    }
};
struct FGU {
    bf16* H;
    __device__ __forceinline__ void operator()(int row, int col, f32x4 v, int) const {
        const float h0 = v.x / (1.f + __expf(-v.x)) * v.y, h1 = v.z / (1.f + __expf(-v.z)) * v.w;
        *(GAS unsigned*)(H + (size_t)row * DFF + (col >> 1)) = pk2(h0, h1);
    }
};

__device__ __forceinline__ void na_simple(const Args& A, int gthr, int nthr) {
    const bf16* P = (const bf16*)(A.ws + WS_PROJ); bf16* CAT = (bf16*)(A.ws + WS_CAT);
    for (int it = gthr; it < M * NA_HEADS * 2; it += nthr) {
        const int m = it % M, hh = it / M, h = hh >> 1, half = hh & 1;
        const int b = m / SEQ, s = m % SEQ, r = s / GRID_W, c = s % GRID_W;
        int rs = r - NA_KR / 2; rs = rs < 0 ? 0 : (rs > ROWS - NA_KR ? ROWS - NA_KR : rs);
        int cs = c - NA_KC / 2; cs = cs < 0 ? 0 : (cs > GRID_W - NA_KC ? GRID_W - NA_KC : cs);
        float q[64];
        { const GAS v4u* qp = (const GAS v4u*)(P + (size_t)m * INC + O_NAQ + h * 64);
#pragma unroll
          for (int k = 0; k < 8; ++k) { const v4u w = qp[k]; q[8 * k] = bflo(w.x); q[8 * k + 1] = bfhi(w.x); q[8 * k + 2] = bflo(w.y); q[8 * k + 3] = bfhi(w.y); q[8 * k + 4] = bflo(w.z); q[8 * k + 5] = bfhi(w.z); q[8 * k + 6] = bflo(w.w); q[8 * k + 7] = bfhi(w.w); } }
        float o[32];
#pragma unroll
        for (int e = 0; e < 32; ++e) o[e] = 0.f;
        float mx = -1e30f, l = 0.f;
        for (int i = 0; i < NA_KR; ++i)
            for (int j = 0; j < NA_KC; ++j) {
                const size_t kt = (size_t)b * SEQ + (size_t)(rs + i) * GRID_W + (cs + j);
                const GAS v4u* kp = (const GAS v4u*)(P + kt * INC + O_NAK + h * 64);
                float d = 0.f;
#pragma unroll
                for (int k = 0; k < 8; ++k) { const v4u w = kp[k];
                    d += q[8 * k] * bflo(w.x) + q[8 * k + 1] * bfhi(w.x) + q[8 * k + 2] * bflo(w.y) + q[8 * k + 3] * bfhi(w.y) + q[8 * k + 4] * bflo(w.z) + q[8 * k + 5] * bfhi(w.z) + q[8 * k + 6] * bflo(w.w) + q[8 * k + 7] * bfhi(w.w); }
                const float sc = d * 0.125f + A.rpb[(h * 15 + (rs + i - r + NA_KR - 1)) * 31 + (cs + j - c + NA_KC - 1)];
                const float mn = fmaxf(mx, sc), al = __expf(mx - mn), p = __expf(sc - mn); mx = mn; l = l * al + p;
                const GAS v4u* vp = (const GAS v4u*)(P + kt * INC + O_NAV + h * 64 + half * 32);
#pragma unroll
                for (int k = 0; k < 4; ++k) { const v4u w = vp[k];
                    o[8 * k] = o[8 * k] * al + p * bflo(w.x); o[8 * k + 1] = o[8 * k + 1] * al + p * bfhi(w.x); o[8 * k + 2] = o[8 * k + 2] * al + p * bflo(w.y); o[8 * k + 3] = o[8 * k + 3] * al + p * bfhi(w.y);
                    o[8 * k + 4] = o[8 * k + 4] * al + p * bflo(w.z); o[8 * k + 5] = o[8 * k + 5] * al + p * bfhi(w.z); o[8 * k + 6] = o[8 * k + 6] * al + p * bflo(w.w); o[8 * k + 7] = o[8 * k + 7] * al + p * bfhi(w.w); }
            }
        const float il = 1.f / l;
        GAS v4u* op = (GAS v4u*)(CAT + (size_t)m * DM + h * 64 + half * 32);
#pragma unroll
        for (int k = 0; k < 4; ++k) op[k] = (v4u){pk2(o[8 * k] * il, o[8 * k + 1] * il), pk2(o[8 * k + 2] * il, o[8 * k + 3] * il), pk2(o[8 * k + 4] * il, o[8 * k + 5] * il), pk2(o[8 * k + 6] * il, o[8 * k + 7] * il)};
    }
}
__device__ __forceinline__ void da_simple(const Args& A, LAS unsigned char* lds, int tid, int vcu, int G) {
    const bf16* P = (const bf16*)(A.ws + WS_PROJ); float* DAO = A.out;
    LAS float* Ks = (LAS float*)lds; LAS float* Vs = (LAS float*)(lds + 16384);
    for (int it = vcu; it < 2 * 8 * 16 * 4; it += G) {
        const int quarter = it & 3, qb = (it >> 2) & 15, hm = (it >> 6) & 7, b = it >> 9, h = hm >> 1;
        const size_t m = (size_t)b * SEQ + qb * 512 + tid;
        float q[64];
        { const GAS v4u* qp = (const GAS v4u*)(P + m * INC + O_DAQ + hm * 64);
#pragma unroll
          for (int k = 0; k < 8; ++k) { const v4u w = qp[k]; q[8 * k] = bflo(w.x); q[8 * k + 1] = bfhi(w.x); q[8 * k + 2] = bflo(w.y); q[8 * k + 3] = bfhi(w.y); q[8 * k + 4] = bflo(w.z); q[8 * k + 5] = bfhi(w.z); q[8 * k + 6] = bflo(w.w); q[8 * k + 7] = bfhi(w.w); } }
        float o[32];
#pragma unroll
        for (int e = 0; e < 32; ++e) o[e] = 0.f;
        float mx = -1e30f, l = 0.f;
        for (int t = 0; t < SEQ / 64; ++t) {
            __syncthreads();
            { const int key = tid >> 3, ch = tid & 7; const v4u w = *(const GAS v4u*)(P + ((size_t)b * SEQ + t * 64 + key) * INC + O_DAK + hm * 64 + ch * 8);
              LAS f32x4* d = (LAS f32x4*)(Ks + key * 64 + ch * 8); d[0] = (f32x4){bflo(w.x), bfhi(w.x), bflo(w.y), bfhi(w.y)}; d[1] = (f32x4){bflo(w.z), bfhi(w.z), bflo(w.w), bfhi(w.w)}; }
            if (tid < 256) { const int key = tid >> 2, ch = tid & 3; const v4u w = *(const GAS v4u*)(P + ((size_t)b * SEQ + t * 64 + key) * INC + O_DAV + h * 128 + quarter * 32 + ch * 8);
              LAS f32x4* d = (LAS f32x4*)(Vs + key * 32 + ch * 8); d[0] = (f32x4){bflo(w.x), bfhi(w.x), bflo(w.y), bfhi(w.y)}; d[1] = (f32x4){bflo(w.z), bfhi(w.z), bflo(w.w), bfhi(w.w)}; }
            __syncthreads();
            for (int key = 0; key < 64; ++key) {
                const LAS f32x4* kr = (const LAS f32x4*)(Ks + key * 64); float d = 0.f;
#pragma unroll
                for (int k = 0; k < 16; ++k) { const f32x4 kk = kr[k]; d += q[4 * k] * kk.x + q[4 * k + 1] * kk.y + q[4 * k + 2] * kk.z + q[4 * k + 3] * kk.w; }
                const float mn = fmaxf(mx, d), al = __builtin_amdgcn_exp2f(mx - mn), p = __builtin_amdgcn_exp2f(d - mn); mx = mn; l = l * al + p;
                const LAS f32x4* vr = (const LAS f32x4*)(Vs + key * 32);
#pragma unroll
                for (int k = 0; k < 8; ++k) { const f32x4 vv = vr[k]; o[4 * k] = o[4 * k] * al + p * vv.x; o[4 * k + 1] = o[4 * k + 1] * al + p * vv.y; o[4 * k + 2] = o[4 * k + 2] * al + p * vv.z; o[4 * k + 3] = o[4 * k + 3] * al + p * vv.w; }
            }
        }
        const float il = 1.f / l;
        GAS f32x4* op = (GAS f32x4*)(DAO + m * DM + hm * 128 + quarter * 32);
#pragma unroll
        for (int k = 0; k < 8; ++k) op[k] = (f32x4){o[4 * k] * il, o[4 * k + 1] * il, o[4 * k + 2] * il, o[4 * k + 3] * il};
    }
}
__device__ __forceinline__ void da_combine(const Args& A, int lane, int gw, int NGW) {
    const float* DAO = A.out; bf16* CAT = (bf16*)(A.ws + WS_CAT);
    const float lam = __expf(wave_sum(A.lq1[lane] * A.lk1[lane])) - __expf(wave_sum(A.lq2[lane] * A.lk2[lane])) + LAMBDA_INIT;
    const float g0 = A.subln_g[2 * lane], g1 = A.subln_g[2 * lane + 1];
    for (int it = gw; it < M * DA_HEADS; it += NGW) {
        const int m = it >> 2, h = it & 3;
        const f32x2 a = *(const GAS f32x2*)(DAO + (size_t)m * DM + h * 256 + 2 * lane), b = *(const GAS f32x2*)(DAO + (size_t)m * DM + h * 256 + 128 + 2 * lane);
        const float o0 = a.x - lam * b.x, o1 = a.y - lam * b.y;
        const float r = 1.f / sqrtf(wave_sum(o0 * o0 + o1 * o1) * (1.f / 128.f) + LN_EPS);
        *(GAS unsigned*)(CAT + (size_t)m * DM + 512 + h * 128 + 2 * lane) = pk2(o0 * r * g0 * (1.f - LAMBDA_INIT), o1 * r * g1 * (1.f - LAMBDA_INIT));
    }
}

__global__ void __launch_bounds__(NTHR, 2) fwd_kernel(Args A) {
    extern __shared__ __attribute__((aligned(16))) unsigned char lds_raw[];
    LAS unsigned char* lds = (LAS unsigned char*)lds_raw;
    const int tid = threadIdx.x, lane = tid & 63, wave = __builtin_amdgcn_readfirstlane(tid >> 6);
    const int G = gridDim.x; const int bx = blockIdx.x; const int vcu = (G % 8 == 0) ? (bx % 8) * (G / 8) + bx / 8 : bx;
    const int gw = vcu * NWAVES + wave, NGW = G * NWAVES;
    volatile LAS unsigned* MISC = (volatile LAS unsigned*)(lds + MISC_OFF);
    for (int u = tid; u < (LDS_BYTES - LDSCTL_OFF) / 4; u += NTHR) ((LAS unsigned*)(lds + LDSCTL_OFF))[u] = 0u;
    __syncthreads();
    unsigned* barw = (unsigned*)(A.ws + WS_CTL) + CW_BAR;
    XcdBarrier bar; bar.bar = barw; bar.x = 0; bar.st = nullptr;
    const int lo = A.ph_lo, hi = A.ph_hi;
    if (hi - lo > 1) bar = xcd_barrier_post(barw, MISC + 8);
#define IN(k) (lo <= (k) && (k) < hi)
#define SEAM(k) do { if (IN(k) && IN((k) + 1)) xcd_barrier(bar); } while (0)
    unsigned char* ws = A.ws;
    const float* mod = (const float*)(ws + WS_MOD);

    if (IN(0)) { p0_prologue(A, lds, tid, lane, wave, vcu, G); }
    SEAM(0);
    if (IN(1)) { p1_ln_mod(A, lane, gw, NGW); }
    SEAM(1);
    if (IN(2)) {
        pg8::Gemm g{(const bf16*)(ws + WS_XN), (const bf16*)(ws + WS_WIN), M, INC, DM}; pg8::StaticOrder S; S.init(M, INC, G, bx);
        pg8::EpiFn<FProj> E{FProj{(bf16*)(ws + WS_PROJ), (const f32x2*)(ws + WS_ROPE)}};
        pg8::gemm_phase<pg8::EpiFn<FProj>, pg8::StaticOrder, true, true>(lds, g, S, E);
    }
    SEAM(2);
    if (IN(3)) { na_simple(A, vcu * NTHR + tid, G * NTHR); da_simple(A, lds, tid, vcu, G); }
    SEAM(3);
    if (IN(4)) { da_combine(A, lane, gw, NGW); }
    SEAM(4);
    if (IN(5)) {
        pg8::Gemm g{(const bf16*)(ws + WS_CAT), (const bf16*)(ws + WS_WOUT), M, DM, DM}; pg8::StaticOrder S; S.init(M, DM, G, bx);
        pg8::EpiFn<FRes> E{FRes{A.x, A.out, mod + 2048}};
        pg8::gemm_phase<pg8::EpiFn<FRes>, pg8::StaticOrder, true, true>(lds, g, S, E);
    }
    SEAM(5);
    if (IN(6)) { ln_affine_pass<true>(A, A.ln1_g, A.ln1_b, lane, gw, NGW); }
    SEAM(6);
    if (IN(7)) {
        pg8::Gemm g{(const bf16*)(ws + WS_XN), (const bf16*)(ws + WS_WGU), M, NGU, DM}; pg8::StaticOrder S; S.init(M, NGU, G, bx);
        pg8::EpiFn<FGU> E{FGU{(bf16*)(ws + WS_H)}};
        pg8::gemm_phase<pg8::EpiFn<FGU>, pg8::StaticOrder, true, true>(lds, g, S, E);
    }
    SEAM(7);
    if (IN(8)) {
        pg8::Gemm g{(const bf16*)(ws + WS_H), (const bf16*)(ws + WS_WD), M, DM, DFF}; pg8::StaticOrder S; S.init(M, DM, G, bx);
        pg8::EpiFn<FRes> E{FRes{A.out, A.out, mod + 5120}};
        pg8::gemm_phase<pg8::EpiFn<FRes>, pg8::StaticOrder, true, true>(lds, g, S, E);
    }
    SEAM(8);
    if (IN(9)) { ln_affine_pass<false>(A, A.ln2_g, A.ln2_b, lane, gw, NGW); }
#undef IN
#undef SEAM
}

extern "C" void kernel_launch(void* const* d_in, const int* in_sizes, int n_in, void* d_out, int out_size, void* d_ws, size_t ws_size, hipStream_t stream) {
    static int grid = 0;
    if (grid == 0) {
        if (n_in != 19 || in_sizes[0] != M * DM || out_size != M * DM || ws_size < WS_END) { fprintf(stderr, "kernel_launch: unexpected shapes (n_in %d, in0 %d, out %d, ws %zu)\n", n_in, n_in > 0 ? in_sizes[0] : -1, out_size, ws_size); grid = -1; return; }
        int dev = 0, cus = 0, per_cu = 0;
        if (hipGetDevice(&dev) != hipSuccess || hipDeviceGetAttribute(&cus, hipDeviceAttributeMultiprocessorCount, dev) != hipSuccess) { grid = -1; return; }
        if (hipFuncSetAttribute((const void*)fwd_kernel, hipFuncAttributeMaxDynamicSharedMemorySize, LDS_BYTES) != hipSuccess) { fprintf(stderr, "kernel_launch: hipFuncSetAttribute failed\n"); grid = -1; return; }
        if (hipOccupancyMaxActiveBlocksPerMultiprocessor(&per_cu, (const void*)fwd_kernel, NTHR, LDS_BYTES) != hipSuccess || per_cu < 1) { fprintf(stderr, "kernel_launch: occupancy query says %d blocks/CU\n", per_cu); (void)hipGetLastError(); grid = -1; return; }
        grid = cus;
    }
    if (grid < 0) return;
    Args a{};
    a.x = (const float*)d_in[0]; a.c = (const float*)d_in[1]; a.w_ada = (const float*)d_in[2]; a.b_ada = (const float*)d_in[3]; a.w_in = (const float*)d_in[4]; a.rpb = (const float*)d_in[5];
    a.lq1 = (const float*)d_in[6]; a.lk1 = (const float*)d_in[7]; a.lq2 = (const float*)d_in[8]; a.lk2 = (const float*)d_in[9]; a.subln_g = (const float*)d_in[10]; a.w_out = (const float*)d_in[11];
    a.ln1_g = (const float*)d_in[12]; a.ln1_b = (const float*)d_in[13]; a.w_gate = (const float*)d_in[14]; a.w_up = (const float*)d_in[15]; a.w_down = (const float*)d_in[16]; a.ln2_g = (const float*)d_in[17]; a.ln2_b = (const float*)d_in[18];
    a.out = (float*)d_out; a.ws = (unsigned char*)d_ws;
    for (int i = 0; i < 32; ++i) a.freq[i] = 1.0f / powf(10000.0f, (float)i / 32.0f);
    if (MK_N_LAUNCHES == 1) {
        if (hipMemsetAsync((char*)d_ws + WS_CTL, 0, CTL_ZERO_BYTES, stream) != hipSuccess) return;
        a.ph_lo = 0; a.ph_hi = N_PHASES;
        hipLaunchKernelGGL(fwd_kernel, dim3(grid), dim3(NTHR), LDS_BYTES, stream, a);
    } else {
        for (int p = 0; p < N_PHASES; ++p) { a.ph_lo = p; a.ph_hi = p + 1; hipLaunchKernelGGL(fwd_kernel, dim3(grid), dim3(NTHR), LDS_BYTES, stream, a); }
    }
    const hipError_t le = hipPeekAtLastError();
    if (le != hipSuccess) fprintf(stderr, "kernel_launch: launch failed: %s\n", hipGetErrorName(le));
}
```

```cpp
#include <hip/hip_runtime.h>
#include <cstdio>
#include <cstdint>
#include <cmath>

#ifndef MK_N_LAUNCHES
#define MK_N_LAUNCHES 1
#endif

constexpr int BATCH = 2, SEQ = 8192, DM = 1024, M = BATCH * SEQ;
constexpr int GRID_W = 64, NA_HEADS = 8, HD = 64, NA_KR = 8, NA_KC = 16, ROWS = SEQ / GRID_W;
constexpr int DA_HEADS = 4, DA_V = 128;
constexpr int INC = 3072, DFF = 2816, NGU = 2 * DFF;
constexpr int O_NAQ = 0, O_NAK = 512, O_NAV = 1024, O_DAQ = 1536, O_DAK = 2048, O_DAV = 2560;
constexpr float LN_EPS = 1e-5f;
constexpr float ALPHA = 1.189207115002721f;
constexpr float LAMBDA_INIT = 0.2f;
constexpr float C2 = 0.125f * 1.4426950408889634f;

namespace pg8 {
#define PG8_LAS __attribute__((address_space(3)))
typedef unsigned short bf16_t;
typedef short bf16x8 __attribute__((ext_vector_type(8)));
typedef float f32x4 __attribute__((ext_vector_type(4)));
typedef unsigned u32x4 __attribute__((ext_vector_type(4)));
constexpr int BM = 256, BK = 64, HALF = 128, HTB = HALF * BK * 2, STAGE_BYTES = 8 * HTB, NXCD = 8, WGM = 8;

__host__ __device__ __forceinline__ int lds_byte(int r, int c) { const int st = (r >> 4) * 2 + (c >> 5), rr = r & 15, cc = c & 31, ob = rr * 64 + cc * 2; return st * 1024 + (ob ^ (((ob >> 9) & 1) << 5)); }
__host__ __device__ __forceinline__ void stage_rc(int b, int& R, int& C) { const int st = b / 1024, sb = b % 1024, swz = sb ^ (((sb >> 9) & 1) << 5); R = (st >> 1) * 16 + swz / 64; C = (st & 1) * 32 + (swz % 64) / 2; }
__host__ __device__ __forceinline__ int perm32(int rho) { const int n = rho >> 4, i = rho & 15; return 8 * (i >> 2) + 4 * n + (i & 3); }

struct Unit { int pm, pn; };
struct Gemm { const bf16_t* A; const bf16_t* Bt; int M, N, K; };

struct StaticOrder {
    int nM, nN, nwg, G, c;
    __host__ __device__ void init(int M_, int N_, int G_, int c_) { nM = M_ / BM; nN = N_ / BM; nwg = nM * nN; G = G_; c = c_; }
    __host__ __device__ bool next(int i, Unit& u) const {
        const long L = (long)i * G + c; if (L >= nwg) return false;
        int wgid = (int)L; { const int q = nwg / NXCD, r = nwg % NXCD, xcd = wgid % NXCD, off = wgid / NXCD; wgid = (xcd < r ? xcd * (q + 1) : r * (q + 1) + (xcd - r) * q) + off; }
        const int nig = WGM * nN, gid = wgid / nig, fm = gid * WGM, gsz = (nM - fm) < WGM ? (nM - fm) : WGM;
        u.pm = fm + ((wgid % nig) % gsz); u.pn = (wgid % nig) / gsz; return true;
    }
    __device__ __forceinline__ void a_ready(const Unit&) const {}
    __device__ __forceinline__ void done(const Unit&) const {}
};

template <class F> struct EpiFn {
    static constexpr bool PERM = false, AFTER_DRAIN = false; F f;
    __device__ __forceinline__ void operator()(const f32x4 (&acc)[2][2][4][2], const Unit& u, int wr, int wc, int fr, int fq) const {
        asm volatile("" : "+v"(fr), "+v"(fq));
#pragma unroll
        for (int ai = 0; ai < 2; ++ai)
#pragma unroll
            for (int m = 0; m < 4; ++m) { const int row = u.pm * BM + ai * HALF + wr * 64 + m * 16 + fr;
#pragma unroll
                for (int bj = 0; bj < 2; ++bj)
#pragma unroll
                    for (int n = 0; n < 2; ++n) f(row, u.pn * BM + bj * HALF + wc * 32 + n * 16 + 4 * fq, acc[ai][bj][m][n], u.pn); }
    }
    __device__ __forceinline__ void fused(f32x4 (&)[2][2][4][2], const Unit&, int, int, int, int, PG8_LAS unsigned char*, int, int) const {}
};

template <class Epi, class Sched, bool ALIGN_EPI = false, bool SP2 = false>
__device__ __forceinline__ void gemm_phase(PG8_LAS unsigned char* lds, const Gemm g, const Sched& S, const Epi& E) {
    const int tid = threadIdx.x, wid = __builtin_amdgcn_readfirstlane(tid >> 6), lane = tid & 63, wr = wid >> 2, wc = wid & 3, fr = lane & 15, fq = lane >> 4;
    const int K = g.K, nt = K / BK;
    unsigned voffA[2], voffB[2];
#pragma unroll
    for (int i = 0; i < 2; ++i) { int R, C; stage_rc(tid * 16 + i * 8192, R, C); const int Rb = Epi::PERM ? ((R & ~31) + perm32(R & 31)) : R;
        voffA[i] = (unsigned)(R * K + C) * 2u; voffB[i] = (unsigned)(Rb * K + C) * 2u; }
    const size_t kstep = (size_t)(BK * 2);
    const size_t hstep = (size_t)HALF * K * 2;
    const size_t tstep = 2 * hstep;
    const unsigned ldsw = (unsigned)wid * 1024u;
    const int aoff = lds_byte(wr * 64 + fr, fq * 8), boff = lds_byte(wc * 32 + fr, fq * 8);
#define PG8_SA(b, h) (((b) * 2 + (h)) * HTB)
#define PG8_SB(b, h) ((4 + (b) * 2 + (h)) * HTB)
#define PG8_STAGE(bufoff, gbase, voff) do { _Pragma("unroll") for (int _i = 0; _i < 2; ++_i) \
        __builtin_amdgcn_global_load_lds((const unsigned*)((const char*)(gbase) + (voff)[_i]), (PG8_LAS unsigned*)(lds + (bufoff) + ldsw + _i * 8192), 16, 0, 0); } while (0)
#define PG8_LDA(dst, b, h) do { _Pragma("unroll") for (int m = 0; m < 4; ++m) _Pragma("unroll") for (int k = 0; k < 2; ++k) dst[m][k] = *(const PG8_LAS bf16x8*)(lds + PG8_SA(b, h) + aoff + m * 2048 + k * 1024); } while (0)
#define PG8_LDB(dst, b, h) do { _Pragma("unroll") for (int n = 0; n < 2; ++n) _Pragma("unroll") for (int k = 0; k < 2; ++k) dst[n][k] = *(const PG8_LAS bf16x8*)(lds + PG8_SB(b, h) + boff + n * 2048 + k * 1024); } while (0)
#define PG8_MMA(ai, bj, At, Bt) do { __builtin_amdgcn_s_setprio(1); _Pragma("unroll") for (int m = 0; m < 4; ++m) _Pragma("unroll") for (int n = 0; n < 2; ++n) _Pragma("unroll") for (int k = 0; k < 2; ++k) \
        acc[ai][bj][m][n] = __builtin_amdgcn_mfma_f32_16x16x32_bf16(Bt[n][k], At[m][k], acc[ai][bj][m][n], 0, 0, 0); __builtin_amdgcn_s_setprio(0); } while (0)
#define PG8_WAIT_V(n) asm volatile("s_waitcnt vmcnt(" #n ")" ::: "memory")
#define PG8_WAIT_L(n) asm volatile("s_waitcnt lgkmcnt(" #n ")" ::: "memory")
#define PG8_BAR __builtin_amdgcn_s_barrier()
#define PG8_SCHED __builtin_amdgcn_sched_barrier(0)
    Unit cur, nxt; int ui = 0;
    if (!S.next(0, cur)) return;
    f32x4 acc[2][2][4][2];
#pragma unroll
    for (int a = 0; a < 2; ++a)
#pragma unroll
        for (int b = 0; b < 2; ++b)
#pragma unroll
            for (int m = 0; m < 4; ++m)
#pragma unroll
                for (int n = 0; n < 2; ++n) acc[a][b][m][n] = (f32x4){0.f, 0.f, 0.f, 0.f};
    bf16x8 At[4][2], B0[2][2], B1[2][2];
    const char* cA = (const char*)g.A + (size_t)cur.pm * tstep; const char* cB = (const char*)g.Bt + (size_t)cur.pn * tstep;
    S.a_ready(cur);
    if constexpr (SP2) {
        PG8_STAGE(PG8_SB(0, 0), cB, voffB); PG8_STAGE(PG8_SB(0, 1), cB + hstep, voffB); PG8_STAGE(PG8_SA(0, 0), cA, voffA); PG8_STAGE(PG8_SA(0, 1), cA + hstep, voffA);
        if (wr == 1) PG8_BAR;
        PG8_WAIT_V(2); PG8_BAR;
        PG8_STAGE(PG8_SB(1, 0), cB + kstep, voffB); PG8_STAGE(PG8_SA(1, 0), cA + kstep, voffA); PG8_STAGE(PG8_SB(1, 1), cB + hstep + kstep, voffB);
        PG8_WAIT_V(6); PG8_BAR;
    } else {
        PG8_STAGE(PG8_SB(0, 0), cB, voffB); PG8_STAGE(PG8_SA(0, 0), cA, voffA); PG8_STAGE(PG8_SB(0, 1), cB + hstep, voffB); PG8_STAGE(PG8_SA(0, 1), cA + hstep, voffA);
        if (wr == 1) PG8_BAR;
        PG8_WAIT_V(4); PG8_BAR;
        PG8_STAGE(PG8_SB(1, 0), cB + kstep, voffB); PG8_STAGE(PG8_SA(1, 0), cA + kstep, voffA); PG8_STAGE(PG8_SB(1, 1), cB + hstep + kstep, voffB);
        PG8_WAIT_V(6); PG8_BAR;
    }
    for (;;) {
        const bool has_next = S.next(ui + 1, nxt);
        const char* nA = has_next ? (const char*)g.A + (size_t)nxt.pm * tstep : cA; const char* nB = has_next ? (const char*)g.Bt + (size_t)nxt.pn * tstep : cB;
        for (int t = 0; t < nt; t += 2) {
            const bool last = (t == nt - 2);
            const char* a1 = cA + (size_t)(t + 1) * kstep;
            const char* a2 = last ? nA : cA + (size_t)(t + 2) * kstep; const char* b2 = last ? nB : cB + (size_t)(t + 2) * kstep;
            const char* a3 = a2 + kstep; const char* b3 = b2 + kstep;
            if (last && has_next) S.a_ready(nxt);
            if constexpr (SP2) {
            PG8_LDB(B0, 0, 0); PG8_LDB(B1, 0, 1); PG8_SCHED; PG8_LDA(At, 0, 0); PG8_STAGE(PG8_SA(1, 1), a1 + hstep, voffA);
            PG8_WAIT_V(8); PG8_WAIT_L(0); PG8_BAR; PG8_MMA(0, 0, At, B0); PG8_MMA(0, 1, At, B1); PG8_BAR; PG8_SCHED;
            PG8_LDA(At, 0, 1); PG8_STAGE(PG8_SB(0, 0), b2, voffB); PG8_STAGE(PG8_SB(0, 1), b2 + hstep, voffB); PG8_STAGE(PG8_SA(0, 0), a2, voffA);
            PG8_WAIT_V(8); PG8_WAIT_L(0); PG8_BAR; PG8_MMA(1, 0, At, B0); PG8_MMA(1, 1, At, B1); PG8_BAR; PG8_SCHED;
            PG8_LDB(B0, 1, 0); PG8_LDB(B1, 1, 1); PG8_SCHED; PG8_LDA(At, 1, 0); PG8_STAGE(PG8_SA(0, 1), a2 + hstep, voffA);
            PG8_WAIT_V(8); PG8_WAIT_L(0); PG8_BAR; PG8_MMA(0, 0, At, B0); PG8_MMA(0, 1, At, B1); PG8_BAR; PG8_SCHED;
            PG8_LDA(At, 1, 1); PG8_STAGE(PG8_SB(1, 0), b3, voffB); PG8_STAGE(PG8_SB(1, 1), b3 + hstep, voffB); PG8_STAGE(PG8_SA(1, 0), a3, voffA);
            PG8_WAIT_V(8); PG8_WAIT_L(0); PG8_BAR; PG8_MMA(1, 0, At, B0); PG8_MMA(1, 1, At, B1); PG8_BAR; PG8_SCHED;
            } else {
            PG8_LDB(B0, 0, 0); PG8_SCHED; PG8_LDA(At, 0, 0); PG8_STAGE(PG8_SA(1, 1), a1 + hstep, voffA);
            PG8_WAIT_L(8); PG8_BAR; PG8_WAIT_L(0); PG8_MMA(0, 0, At, B0); PG8_BAR; PG8_SCHED;
            PG8_LDB(B1, 0, 1); PG8_STAGE(PG8_SB(0, 0), b2, voffB);
            PG8_BAR; PG8_WAIT_L(0); PG8_MMA(0, 1, At, B1); PG8_BAR;
            PG8_LDA(At, 0, 1); PG8_STAGE(PG8_SA(0, 0), a2, voffA);
            PG8_BAR; PG8_WAIT_L(0); PG8_MMA(1, 0, At, B0); PG8_BAR; PG8_SCHED;
            PG8_STAGE(PG8_SB(0, 1), b2 + hstep, voffB);
            PG8_WAIT_V(6); PG8_BAR; PG8_MMA(1, 1, At, B1); PG8_BAR;
            PG8_LDB(B0, 1, 0); PG8_SCHED; PG8_LDA(At, 1, 0); PG8_STAGE(PG8_SA(0, 1), a2 + hstep, voffA);
            PG8_WAIT_L(8); PG8_BAR; PG8_WAIT_L(0); PG8_MMA(0, 0, At, B0); PG8_BAR; PG8_SCHED;
            PG8_LDB(B1, 1, 1); PG8_STAGE(PG8_SB(1, 0), b3, voffB);
            PG8_BAR; PG8_WAIT_L(0); PG8_MMA(0, 1, At, B1); PG8_BAR;
            PG8_LDA(At, 1, 1); PG8_STAGE(PG8_SA(1, 0), a3, voffA);
            PG8_BAR; PG8_WAIT_L(0); PG8_MMA(1, 0, At, B0); PG8_BAR; PG8_SCHED;
            PG8_STAGE(PG8_SB(1, 1), b3 + hstep, voffB);
            PG8_WAIT_V(6); PG8_BAR; PG8_MMA(1, 1, At, B1); PG8_BAR;
            }
        }
        if constexpr (ALIGN_EPI) { if (wr == 0) PG8_BAR; }
        if constexpr (!Epi::AFTER_DRAIN) { E(acc, cur, wr, wc, fr, fq); S.done(cur); }
        if (!has_next) break;
#pragma unroll
        for (int a = 0; a < 2; ++a)
#pragma unroll
            for (int b = 0; b < 2; ++b)
#pragma unroll
                for (int m = 0; m < 4; ++m)
#pragma unroll
                    for (int n = 0; n < 2; ++n) acc[a][b][m][n] = (f32x4){0.f, 0.f, 0.f, 0.f};
        cur = nxt; cA = nA; cB = nB; ++ui;
        if constexpr (ALIGN_EPI) { if (wr == 1) PG8_BAR; }
    }
    PG8_WAIT_V(0);
    if constexpr (!ALIGN_EPI) { if (wr == 0) PG8_BAR; }
    PG8_BAR;
    if constexpr (Epi::AFTER_DRAIN) { E.fused(acc, cur, wr, wc, fr, fq, lds, wid, lane); S.done(cur); }
#undef PG8_SA
#undef PG8_SB
#undef PG8_STAGE
#undef PG8_LDA
#undef PG8_LDB
#undef PG8_MMA
#undef PG8_WAIT_V
#undef PG8_WAIT_L
#undef PG8_BAR
#undef PG8_SCHED
}
}

constexpr int NWAVES = 8, NTHR = NWAVES * 64;
constexpr int N_PHASES = 9;
constexpr size_t MiB = 1u << 20;
constexpr size_t WS_CTL = 0, CTL_ZERO_BYTES = 64 * 1024;
constexpr size_t WS_MOD = 1 * MiB;
constexpr size_t WS_ROPE = 2 * MiB;
constexpr size_t WS_WIN = 4 * MiB;
constexpr size_t WS_WOUT = 10 * MiB;
constexpr size_t WS_WGU = 12 * MiB;
constexpr size_t WS_WD = 23 * MiB;
constexpr size_t WS_XN = 32 * MiB;
constexpr size_t WS_PROJ = 64 * MiB;
constexpr size_t WS_H = WS_PROJ;
constexpr size_t WS_CAT = 160 * MiB;
constexpr size_t WS_DAK = 192 * MiB;
constexpr size_t WS_DAV = 208 * MiB;
constexpr size_t WS_O1 = 224 * MiB;
constexpr size_t WS_END = 256 * MiB;
constexpr int CW_BAR = 1024;
constexpr int RING_BYTES = 131072, LDSCTL_OFF = RING_BYTES, MISC_OFF = LDSCTL_OFF + 320, LDS_BYTES = 147456;

#define GAS __attribute__((address_space(1)))
#define LAS __attribute__((address_space(3)))
typedef unsigned short bf16;
typedef unsigned v4u __attribute__((ext_vector_type(4)));
typedef unsigned v2u __attribute__((ext_vector_type(2)));
typedef float f32x4 __attribute__((ext_vector_type(4)));
typedef float f32x2 __attribute__((ext_vector_type(2)));
#define LDS_WAIT() asm volatile("s_waitcnt lgkmcnt(0)" ::: "memory")
#define VM_WAIT() asm volatile("s_waitcnt vmcnt(0)" ::: "memory")
__device__ __forceinline__ unsigned f2bf(float f) { unsigned u = __builtin_bit_cast(unsigned, f); return (u + 0x7fffu + ((u >> 16) & 1u)) >> 16; }
__device__ __forceinline__ unsigned pk2(float lo, float hi) { return f2bf(lo) | (f2bf(hi) << 16); }
__device__ __forceinline__ float bflo(unsigned w) { return __builtin_bit_cast(float, w << 16); }
__device__ __forceinline__ float bfhi(unsigned w) { return __builtin_bit_cast(float, w & 0xffff0000u); }
__device__ __forceinline__ float wave_sum(float v) {
#pragma unroll
    for (int o = 1; o < 64; o <<= 1) v += __shfl_xor(v, o);
    return v;
}

#define XB_TMO      128
#define XB_XCNT(j)  (256  + 64 * (j))
#define XB_XSUB(j)  (1280 + 64 * (j))
#define XB_XGEN(j)  (2304 + 64 * (j))
#define XB_TOP      3328
#define XB_TOPGEN   3392
#define XCD_BAR_WORDS 3456
#define XB_SPIN_CAP (1u << 18)
__device__ __forceinline__ unsigned xb_ld(unsigned* p)              { return __hip_atomic_load(p, __ATOMIC_RELAXED, __HIP_MEMORY_SCOPE_AGENT); }
__device__ __forceinline__ unsigned xb_add(unsigned* p, unsigned v) { return __hip_atomic_fetch_add(p, v, __ATOMIC_RELAXED, __HIP_MEMORY_SCOPE_AGENT); }
__device__ __forceinline__ unsigned xb_xcc_id() { return (unsigned)__builtin_amdgcn_s_getreg((3 << 11) | 20) & 0xFu; }
#define XB_SPIN(cond, bar) do { unsigned _sp = 0; while (cond) { __builtin_amdgcn_s_sleep(1); \
    if ((++_sp & 255u) == 0u) { if (xb_ld(&(bar)[XB_TMO])) break; if (_sp > XB_SPIN_CAP) { atomicAdd(&(bar)[XB_TMO], 1u); break; } } } } while (0)
struct XcdBarrier { unsigned* bar; unsigned x; volatile LAS unsigned* st; };
__device__ __forceinline__ XcdBarrier xcd_barrier_post(unsigned* bar, volatile LAS unsigned* st) {
    XcdBarrier b; b.bar = bar; b.x = xb_xcc_id(); b.st = st;
    if (threadIdx.x == 0) (void)xb_add(&bar[XB_XCNT(b.x)], 1u);
    return b;
}
__device__ __forceinline__ void xcd_barrier_complete(unsigned* bar, unsigned x, unsigned& nloc, unsigned& nx) {
    const unsigned G = gridDim.x * gridDim.y * gridDim.z;
    unsigned sum, cnt, mine, sp = 0u;
    for (;;) {
        sum = 0u; cnt = 0u; mine = 0u;
#pragma unroll
        for (unsigned j = 0; j < 16; ++j) { const unsigned c = xb_ld(&bar[XB_XCNT(j)]); sum += c; cnt += (c > 0u) ? 1u : 0u; mine = (j == x) ? c : mine; }
        if (sum == G) break;
        __builtin_amdgcn_s_sleep(1);
        if ((++sp & 255u) == 0u) { if (xb_ld(&bar[XB_TMO])) break; if (sp > XB_SPIN_CAP) { atomicAdd(&bar[XB_TMO], 1u); break; } }
    }
    nloc = mine > 0u ? mine : 1u; nx = cnt > 0u ? cnt : 1u;
}
__device__ __forceinline__ void xcd_barrier(const XcdBarrier& b) {
    asm volatile("s_waitcnt vmcnt(0)" ::: "memory");
    __syncthreads();
    if (threadIdx.x == 0) {
        unsigned* bar = b.bar;
        __builtin_amdgcn_s_waitcnt(0);
        unsigned nloc = b.st[0], nx = b.st[1];
        if (nloc == 0u) { xcd_barrier_complete(bar, b.x, nloc, nx); b.st[0] = nloc; b.st[1] = nx; }
        const unsigned old = xb_add(&bar[XB_XSUB(b.x)], 1u);
        const unsigned gen = old / nloc;
        if (old + 1u == (gen + 1u) * nloc) {
            __builtin_amdgcn_fence(__ATOMIC_RELEASE, "agent");
            asm volatile("s_waitcnt vmcnt(0)" ::: "memory");
            const unsigned og = xb_add(&bar[XB_TOP], 1u);
            const unsigned tg = og / nx;
            if (og + 1u == (tg + 1u) * nx) xb_add(&bar[XB_TOPGEN], 1u);
            else XB_SPIN(xb_ld(&bar[XB_TOPGEN]) == tg, bar);
            __builtin_amdgcn_fence(__ATOMIC_ACQUIRE, "agent");
            xb_add(&bar[XB_XGEN(b.x)], 1u);
            asm volatile("s_waitcnt vmcnt(0)" ::: "memory");
        } else {
            XB_SPIN(xb_ld(&bar[XB_XGEN(b.x)]) == gen, bar);
            __builtin_amdgcn_fence(__ATOMIC_ACQUIRE, "agent");
            asm volatile("s_waitcnt vmcnt(0)" ::: "memory");
        }
    }
    __syncthreads();
}

struct Args {
    const float* x; const float* c; const float* w_ada; const float* b_ada; const float* w_in; const float* rpb;
    const float* lq1; const float* lk1; const float* lq2; const float* lk2; const float* subln_g; const float* w_out;
    const float* ln1_g; const float* ln1_b; const float* w_gate; const float* w_up; const float* w_down; const float* ln2_g; const float* ln2_b;
    float* out; unsigned char* ws; int ph_lo, ph_hi; float freq[32];
};

__device__ __forceinline__ int dst_row(int mat, int n) {
    if (mat == 0) { if (n < O_DAQ || n >= O_DAV) return n; const int d = n & 63; return (n & ~63) + (d < 32 ? 2 * d : 2 * (d - 32) + 1); }
    if (mat == 2) return 2 * n;
    if (mat == 3) return 2 * n + 1;
    return n;
}
__device__ __forceinline__ void p0_transpose_item(const float* W, int K, int N, bf16* WT, int mat, LAS float* scr, int item, int lane) {
    const int nblk = N / 32, kb = item / nblk, nb = item % nblk, k0 = 64 * kb, n0 = 32 * nb;
#pragma unroll 8
    for (int i = 0; i < 32; ++i) { const int kk = 2 * i + (lane >> 5); scr[kk * 33 + (lane & 31)] = W[(size_t)(k0 + kk) * N + n0 + (lane & 31)]; }
    LDS_WAIT(); asm volatile("" ::: "memory");
    const int c = lane & 7;
#pragma unroll
    for (int j = 0; j < 4; ++j) { const int n = (lane >> 3) + 8 * j; const LAS float* s = scr + (8 * c) * 33 + n;
        v4u o; o.x = pk2(s[0 * 33], s[1 * 33]); o.y = pk2(s[2 * 33], s[3 * 33]); o.z = pk2(s[4 * 33], s[5 * 33]); o.w = pk2(s[6 * 33], s[7 * 33]);
        *(GAS v4u*)(WT + (size_t)dst_row(mat, n0 + n) * K + k0 + 8 * c) = o; }
    LDS_WAIT(); asm volatile("" ::: "memory");
}
__device__ __forceinline__ void sincos_d(double a, float& co, float& si) {
    const double k = __builtin_rint(a * 0.63661977236758134308);
    const double r = __builtin_fma(-k, 1.57079632679489661923, a) - k * 6.123233995736766e-17;
    const double r2 = r * r;
    double s = -2.5052108385441718775e-8; s = s * r2 + 2.7557319223985890653e-6; s = s * r2 - 1.9841269841269841270e-4; s = s * r2 + 8.3333333333333333333e-3; s = s * r2 - 1.6666666666666666667e-1; s = s * r2 * r + r;
    double c = 2.0876756987868098979e-9; c = c * r2 - 2.7557319223985890653e-7; c = c * r2 + 2.4801587301587301587e-5; c = c * r2 - 1.3888888888888888889e-3; c = c * r2 + 4.1666666666666666667e-2; c = c * r2 - 0.5; c = c * r2 + 1.0;
    const int q = (int)((long long)k & 3);
    const double cc = (q == 0) ? c : (q == 1) ? -s : (q == 2) ? -c : s;
    const double ss = (q == 0) ? s : (q == 1) ? c : (q == 2) ? -s : -c;
    co = (float)cc; si = (float)ss;
}
__device__ __forceinline__ void p0_prologue(const Args& A, LAS unsigned char* lds, int tid, int lane, int wave, int vcu, int G) {
    unsigned char* ws = A.ws;
    { LAS float* part = (LAS float*)lds;
      float* mod = (float*)(ws + WS_MOD);
      for (int it = vcu; it < 6144 / 32; it += G) {
          const int col = tid & 31, ks = tid >> 5, j = it * 32 + col; float a0 = 0.f, a1 = 0.f;
#pragma unroll 8
          for (int k = ks * 64; k < ks * 64 + 64; ++k) { const float w = A.w_ada[(size_t)k * 6144 + j]; const float c0 = A.c[k], c1 = A.c[1024 + k];
              a0 += (c0 / (1.f + __expf(-c0))) * w; a1 += (c1 / (1.f + __expf(-c1))) * w; }
          part[(0 * 16 + ks) * 32 + col] = a0; part[(1 * 16 + ks) * 32 + col] = a1;
          __syncthreads();
          if (tid < 64) { const int b = tid >> 5, cc = tid & 31; float s = A.b_ada[it * 32 + cc];
#pragma unroll
              for (int q = 0; q < 16; ++q) s += part[(b * 16 + q) * 32 + cc];
              mod[b * 6144 + it * 32 + cc] = s; }
          __syncthreads();
      } }
    { f32x2* tab = (f32x2*)(ws + WS_ROPE);
      for (int e = vcu * NTHR + tid; e < SEQ * 32; e += G * NTHR) { const int pos = e >> 5, i = e & 31; const float ang = (float)pos * A.freq[i]; float co, si; sincos_d((double)ang, co, si); tab[e] = (f32x2){co, si}; } }
    { LAS float* scr = (LAS float*)(lds + wave * 16384);
      const int gw = vcu * NWAVES + wave, NGW = G * NWAVES;
      constexpr int I_IN = (DM / 64) * (INC / 32), I_OUT = (DM / 64) * (DM / 32), I_G = (DM / 64) * (DFF / 32), I_D = (DFF / 64) * (DM / 32);
      constexpr int NITEMS = I_IN + I_OUT + 2 * I_G + I_D;
      for (int it = gw; it < NITEMS; it += NGW) {
          int r = it;
          if (r < I_IN) { p0_transpose_item(A.w_in, DM, INC, (bf16*)(ws + WS_WIN), 0, scr, r, lane); continue; } r -= I_IN;
          if (r < I_OUT) { p0_transpose_item(A.w_out, DM, DM, (bf16*)(ws + WS_WOUT), 1, scr, r, lane); continue; } r -= I_OUT;
          if (r < I_G) { p0_transpose_item(A.w_gate, DM, DFF, (bf16*)(ws + WS_WGU), 2, scr, r, lane); continue; } r -= I_G;
          if (r < I_G) { p0_transpose_item(A.w_up, DM, DFF, (bf16*)(ws + WS_WGU), 3, scr, r, lane); continue; } r -= I_G;
          p0_transpose_item(A.w_down, DFF, DM, (bf16*)(ws + WS_WD), 4, scr, r, lane);
      } }
}

__device__ __forceinline__ void p1_ln_mod(const Args& A, int lane, int gw, int NGW) {
    const float* mod = (const float*)(A.ws + WS_MOD); bf16* XN = (bf16*)(A.ws + WS_XN);
    for (int m = gw; m < M; m += NGW) {
        const int b = m / SEQ; const float* sh = mod + b * 6144, *sc = sh + 1024;
        const GAS f32x4* xr = (const GAS f32x4*)(A.x + (size_t)m * DM) + lane;
        f32x4 v[4]; float s = 0.f;
#pragma unroll
        for (int j = 0; j < 4; ++j) { v[j] = xr[64 * j]; s += (v[j].x + v[j].y) + (v[j].z + v[j].w); }
        const float mean = wave_sum(s) * (1.f / DM); float s2 = 0.f;
#pragma unroll
        for (int j = 0; j < 4; ++j) { v[j] = v[j] - mean; s2 += (v[j].x * v[j].x + v[j].y * v[j].y) + (v[j].z * v[j].z + v[j].w * v[j].w); }
        const float rstd = 1.f / sqrtf(wave_sum(s2) * (1.f / DM) + LN_EPS);
        GAS v2u* o8 = (GAS v2u*)(XN + (size_t)m * DM) + lane;
#pragma unroll
        for (int j = 0; j < 4; ++j) { const f32x4 a = *(const f32x4*)(sc + 4 * lane + 256 * j), d = *(const f32x4*)(sh + 4 * lane + 256 * j);
            const f32x4 y = v[j] * rstd * (a + 1.f) + d; o8[64 * j] = (v2u){pk2(y.x, y.y), pk2(y.z, y.w)}; }
    }
}
template <bool XN2> __device__ __forceinline__ void ln_affine_pass(const Args& A, const float* g, const float* bb, int lane, int gw, int NGW) {
    const float* mod = (const float*)(A.ws + WS_MOD); bf16* XN = (bf16*)(A.ws + WS_XN);
    for (int m = gw; m < M; m += NGW) {
        GAS f32x4* yr = (GAS f32x4*)(A.out + (size_t)m * DM) + lane;
        f32x4 v[4]; float s = 0.f;
#pragma unroll
        for (int j = 0; j < 4; ++j) { v[j] = yr[64 * j]; s += (v[j].x + v[j].y) + (v[j].z + v[j].w); }
        const float mean = wave_sum(s) * (1.f / DM); float s2 = 0.f;
#pragma unroll
        for (int j = 0; j < 4; ++j) { v[j] = v[j] - mean; s2 += (v[j].x * v[j].x + v[j].y * v[j].y) + (v[j].z * v[j].z + v[j].w * v[j].w); }
        const float rstd = 1.f / sqrtf(wave_sum(s2) * (1.f / DM) + LN_EPS);
        float t = 0.f;
#pragma unroll
        for (int j = 0; j < 4; ++j) { const f32x4 gg = *(const f32x4*)(g + 4 * lane + 256 * j), be = *(const f32x4*)(bb + 4 * lane + 256 * j);
            v[j] = v[j] * rstd * gg + be; yr[64 * j] = v[j]; t += (v[j].x + v[j].y) + (v[j].z + v[j].w); }
        if constexpr (XN2) {
            const int b = m / SEQ; const float* sh = mod + b * 6144 + 3072, *sc = sh + 1024;
            const float mean2 = wave_sum(t) * (1.f / DM); float t2 = 0.f;
#pragma unroll
            for (int j = 0; j < 4; ++j) { v[j] = v[j] - mean2; t2 += (v[j].x * v[j].x + v[j].y * v[j].y) + (v[j].z * v[j].z + v[j].w * v[j].w); }
            const float rstd2 = 1.f / sqrtf(wave_sum(t2) * (1.f / DM) + LN_EPS);
            GAS v2u* o8 = (GAS v2u*)(XN + (size_t)m * DM) + lane;
#pragma unroll
            for (int j = 0; j < 4; ++j) { const f32x4 a = *(const f32x4*)(sc + 4 * lane + 256 * j), d = *(const f32x4*)(sh + 4 * lane + 256 * j);
                const f32x4 y = v[j] * rstd2 * (a + 1.f) + d; o8[64 * j] = (v2u){pk2(y.x, y.y), pk2(y.z, y.w)}; }
        }
    }
}

struct FProj {
    unsigned char* wsb;
    __device__ __forceinline__ void operator()(int row, int col, f32x4 v, int pn) const {
        bf16* P = (bf16*)(wsb + WS_PROJ); const f32x2* tab = (const f32x2*)(wsb + WS_ROPE); unsigned char* kimg = wsb + WS_DAK; unsigned char* vimg = wsb + WS_DAV;
        if (pn >= 6 && pn < 10) {
            const int pos = row & (SEQ - 1), i = (col & 63) >> 1; const f32x2 c0 = tab[pos * 32 + i], c1 = tab[pos * 32 + i + 1];
            const float sc = (pn < 8) ? C2 : 1.f;
            const float a0 = (v.x * c0.x - v.y * c0.y) * sc, b0 = (v.y * c0.x + v.x * c0.y) * sc, a1 = (v.z * c1.x - v.w * c1.y) * sc, b1 = (v.w * c1.x + v.z * c1.y) * sc;
            v = (f32x4){a0, b0, a1, b1};
        }
        const v2u w = (v2u){pk2(v.x, v.y), pk2(v.z, v.w)};
        if (pn < 8) { *(GAS v2u*)(P + (size_t)row * INC + col) = w; }
        else {
            const int b = row / SEQ, s = row & (SEQ - 1), tile = s >> 6, k = s & 63;
            if (pn < 10) { const int cc = col - O_DAK, hm = cc >> 6, slot = cc & 63;
                *(GAS v2u*)(kimg + ((size_t)((b * 8 + hm) * 128 + tile)) * 8192 + (slot >> 3) * 1024 + k * 16 + (slot & 7) * 2) = w; }
            else { const int cc = col - O_DAV, h = cc >> 7, d = cc & 127;
                *(GAS v2u*)(vimg + ((size_t)((b * 4 + h) * 128 + tile)) * 16384 + ((k >> 3) * 4 + (d >> 5)) * 512 + (k & 7) * 64 + (d & 31) * 2) = w; }
        }
    }
};
struct FRes {
    const float* R; float* Y; const float* gate;
    __device__ __forceinline__ void operator()(int row, int col, f32x4 v, int) const {
        const int b = row / SEQ; const f32x4 r = *(const GAS f32x4*)(R + (size_t)row * DM + col), g = *(const f32x4*)(gate + b * 6144 + col);
        *(GAS f32x4*)(Y + (size_t)row * DM + col) = r * ALPHA + (g + 1.f) * v;
    }
};
struct FGU {
    bf16* H;
    __device__ __forceinline__ void operator()(int row, int col, f32x4 v, int) const {
        const float h0 = v.x / (1.f + __expf(-v.x)) * v.y, h1 = v.z / (1.f + __expf(-v.z)) * v.w;
        *(GAS unsigned*)(H + (size_t)row * DFF + (col >> 1)) = pk2(h0, h1);
    }
};

__device__ __forceinline__ void na_simple(const Args& A, int gthr, int nthr) {
    const bf16* P = (const bf16*)(A.ws + WS_PROJ); bf16* CAT = (bf16*)(A.ws + WS_CAT);
    for (int it = gthr; it < M * NA_HEADS * 2; it += nthr) {
        const int m = it % M, hh = it / M, h = hh >> 1, half = hh & 1;
        const int b = m / SEQ, s = m % SEQ, r = s / GRID_W, c = s % GRID_W;
        int rs = r - NA_KR / 2; rs = rs < 0 ? 0 : (rs > ROWS - NA_KR ? ROWS - NA_KR : rs);
        int cs = c - NA_KC / 2; cs = cs < 0 ? 0 : (cs > GRID_W - NA_KC ? GRID_W - NA_KC : cs);
        float q[64];
        { const GAS v4u* qp = (const GAS v4u*)(P + (size_t)m * INC + O_NAQ + h * 64);
#pragma unroll
          for (int k = 0; k < 8; ++k) { const v4u w = qp[k]; q[8 * k] = bflo(w.x); q[8 * k + 1] = bfhi(w.x); q[8 * k + 2] = bflo(w.y); q[8 * k + 3] = bfhi(w.y); q[8 * k + 4] = bflo(w.z); q[8 * k + 5] = bfhi(w.z); q[8 * k + 6] = bflo(w.w); q[8 * k + 7] = bfhi(w.w); } }
        float o[32];
#pragma unroll
        for (int e = 0; e < 32; ++e) o[e] = 0.f;
        float mx = -1e30f, l = 0.f;
        for (int i = 0; i < NA_KR; ++i)
            for (int j = 0; j < NA_KC; ++j) {
                const size_t kt = (size_t)b * SEQ + (size_t)(rs + i) * GRID_W + (cs + j);
                const GAS v4u* kp = (const GAS v4u*)(P + kt * INC + O_NAK + h * 64);
                float d = 0.f;
#pragma unroll
                for (int k = 0; k < 8; ++k) { const v4u w = kp[k];
                    d += q[8 * k] * bflo(w.x) + q[8 * k + 1] * bfhi(w.x) + q[8 * k + 2] * bflo(w.y) + q[8 * k + 3] * bfhi(w.y) + q[8 * k + 4] * bflo(w.z) + q[8 * k + 5] * bfhi(w.z) + q[8 * k + 6] * bflo(w.w) + q[8 * k + 7] * bfhi(w.w); }
                const float sc = d * 0.125f + A.rpb[(h * 15 + (rs + i - r + NA_KR - 1)) * 31 + (cs + j - c + NA_KC - 1)];
                const float mn = fmaxf(mx, sc), al = __expf(mx - mn), p = __expf(sc - mn); mx = mn; l = l * al + p;
                const GAS v4u* vp = (const GAS v4u*)(P + kt * INC + O_NAV + h * 64 + half * 32);
#pragma unroll
                for (int k = 0; k < 4; ++k) { const v4u w = vp[k];
                    o[8 * k] = o[8 * k] * al + p * bflo(w.x); o[8 * k + 1] = o[8 * k + 1] * al + p * bfhi(w.x); o[8 * k + 2] = o[8 * k + 2] * al + p * bflo(w.y); o[8 * k + 3] = o[8 * k + 3] * al + p * bfhi(w.y);
                    o[8 * k + 4] = o[8 * k + 4] * al + p * bflo(w.z); o[8 * k + 5] = o[8 * k + 5] * al + p * bfhi(w.z); o[8 * k + 6] = o[8 * k + 6] * al + p * bflo(w.w); o[8 * k + 7] = o[8 * k + 7] * al + p * bfhi(w.w); }
            }
        const float il = 1.f / l;
        GAS v4u* op = (GAS v4u*)(CAT + (size_t)m * DM + h * 64 + half * 32);
#pragma unroll
        for (int k = 0; k < 4; ++k) op[k] = (v4u){pk2(o[8 * k] * il, o[8 * k + 1] * il), pk2(o[8 * k + 2] * il, o[8 * k + 3] * il), pk2(o[8 * k + 4] * il, o[8 * k + 5] * il), pk2(o[8 * k + 6] * il, o[8 * k + 7] * il)};
    }
}
namespace da {
typedef short bf16x8 __attribute__((ext_vector_type(8)));
typedef short s16x4 __attribute__((ext_vector_type(4)));
typedef float f32x16 __attribute__((ext_vector_type(16)));
typedef __bf16 bf16x2_t __attribute__((ext_vector_type(2)));
constexpr int KSLOT = 8192, VSLOT = 16384, LDS_K = 0, LDS_V = 3 * KSLOT, NT = SEQ / 64;
constexpr float THRL = 8.f;
__device__ __forceinline__ unsigned cvtpk(float lo, float hi) { f32x2 v = {lo, hi}; bf16x2_t b = __builtin_convertvector(v, bf16x2_t); return __builtin_bit_cast(unsigned, b); }
__device__ __forceinline__ s16x4 vtr(const LAS unsigned char* p) { return __builtin_bit_cast(s16x4, __builtin_amdgcn_ds_read_tr16_b64_v4i16((LAS s16x4*)p)); }
#define DA_WAIT_BAR(N) asm volatile("s_waitcnt vmcnt(" #N ") lgkmcnt(0)\n\ts_barrier" ::: "memory")
#define DA_SBAR() __builtin_amdgcn_sched_barrier(0)
__device__ __forceinline__ void qkt(f32x16& p0, f32x16& p1, const LAS unsigned char* kp, const bf16x8 (&qr)[4]) {
    p0 = (f32x16){}; p1 = (f32x16){};
#pragma unroll
    for (int d0 = 0; d0 < 4; ++d0) {
        const bf16x8 k0 = *(const LAS bf16x8*)(kp + d0 * 2048), k1 = *(const LAS bf16x8*)(kp + d0 * 2048 + 512);
        p0 = __builtin_amdgcn_mfma_f32_32x32x16_bf16(k0, qr[d0], p0, 0, 0, 0);
        p1 = __builtin_amdgcn_mfma_f32_32x32x16_bf16(k1, qr[d0], p1, 0, 0, 0); }
}
__device__ __forceinline__ float softmax_tile(f32x16& p0, f32x16& p1, float& m_reg, float& l_reg, bf16x8 (&pf)[4]) {
    float pmax = fmaxf(p0[0], p1[0]);
#pragma unroll
    for (int r = 1; r < 16; ++r) pmax = fmaxf(pmax, fmaxf(p0[r], p1[r]));
    { auto rr = __builtin_amdgcn_permlane32_swap(__float_as_uint(pmax), __float_as_uint(pmax), false, false); pmax = fmaxf(__uint_as_float(rr[0]), __uint_as_float(rr[1])); }
    float alpha = 1.f;
    if (!__builtin_expect(__all(pmax - m_reg <= THRL), 1)) { const float mn = fmaxf(m_reg, pmax); alpha = __builtin_amdgcn_exp2f(m_reg - mn); m_reg = mn; }
#pragma unroll
    for (int r = 0; r < 16; ++r) { p0[r] = __builtin_amdgcn_exp2f(p0[r] - m_reg); p1[r] = __builtin_amdgcn_exp2f(p1[r] - m_reg); }
    float ps = 0.f;
#pragma unroll
    for (int r = 0; r < 16; ++r) ps += p0[r] + p1[r];
    l_reg = l_reg * alpha + ps;
#pragma unroll
    for (int s = 0; s < 2; ++s) {
        v4u w0 = {cvtpk(p0[8 * s], p0[8 * s + 1]), cvtpk(p0[8 * s + 2], p0[8 * s + 3]), cvtpk(p0[8 * s + 4], p0[8 * s + 5]), cvtpk(p0[8 * s + 6], p0[8 * s + 7])};
        v4u w1 = {cvtpk(p1[8 * s], p1[8 * s + 1]), cvtpk(p1[8 * s + 2], p1[8 * s + 3]), cvtpk(p1[8 * s + 4], p1[8 * s + 5]), cvtpk(p1[8 * s + 6], p1[8 * s + 7])};
        pf[s] = __builtin_bit_cast(bf16x8, w0); pf[2 + s] = __builtin_bit_cast(bf16x8, w1); }
    return alpha;
}
__device__ __forceinline__ void pv(f32x16 (&o)[4], const LAS unsigned char* vp, const bf16x8 (&pf)[4]) {
#pragma unroll
    for (int d0 = 0; d0 < 4; ++d0) {
        s16x4 lo[4], hi[4];
#pragma unroll
        for (int s = 0; s < 4; ++s) { lo[s] = vtr(vp + s * 4096 + d0 * 512); hi[s] = vtr(vp + s * 4096 + 2048 + d0 * 512); }
        DA_SBAR();
#pragma unroll
        for (int s = 0; s < 4; ++s) {
            const bf16x8 a = (bf16x8){lo[s][0], lo[s][1], lo[s][2], lo[s][3], hi[s][0], hi[s][1], hi[s][2], hi[s][3]};
            o[d0] = __builtin_amdgcn_mfma_f32_32x32x16_bf16(a, pf[s], o[d0], 0, 0, 0); }
        DA_SBAR();
    }
}
__device__ __forceinline__ void da_unit(const Args& A, LAS unsigned char* lds, int unit, int tid, int lane, int wid) {
    const int b = unit >> 7, h = (unit >> 5) & 3, qb = unit & 31, r32 = lane & 31, hi = lane >> 5;
    const bf16* P = (const bf16*)(A.ws + WS_PROJ);
    const LAS unsigned char* kp0 = lds + LDS_K + hi * 1024 + r32 * 16;
    const LAS unsigned char* vp0 = lds + LDS_V + hi * 256 + ((lane >> 2) & 3) * 64 + ((lane >> 4) & 1) * 32 + (lane & 3) * 8;
    f32x16 o[4];
#pragma unroll 1
    for (int map = 0; map < 2; ++map) {
        const int hm = 2 * h + map;
        const unsigned char* kimg = A.ws + WS_DAK + (size_t)((b * 8 + hm) * 128) * 8192 + wid * 1024 + lane * 16;
        const unsigned char* vimg = A.ws + WS_DAV + (size_t)((b * 4 + h) * 128) * 16384 + wid * 2048 + lane * 16;
#define DA_DMA_K(t, slot) __builtin_amdgcn_global_load_lds((const unsigned*)(kimg + (size_t)(t) * 8192), (LAS unsigned*)(lds + LDS_K + (slot) * KSLOT + wid * 1024), 16, 0, 0)
#define DA_DMA_V(t, slot) do { __builtin_amdgcn_global_load_lds((const unsigned*)(vimg + (size_t)(t) * 16384), (LAS unsigned*)(lds + LDS_V + (slot) * VSLOT + wid * 2048), 16, 0, 0); \
                               __builtin_amdgcn_global_load_lds((const unsigned*)(vimg + (size_t)(t) * 16384 + 1024), (LAS unsigned*)(lds + LDS_V + (slot) * VSLOT + wid * 2048 + 1024), 16, 0, 0); } while (0)
        bf16x8 qr[4];
        { int r32o = r32, hio = hi; asm volatile("" : "+v"(r32o), "+v"(hio));
          const bf16* qrow = P + ((size_t)b * SEQ + qb * 256 + wid * 32 + r32o) * INC + O_DAQ + hm * 64 + hio * 8;
#pragma unroll
          for (int d0 = 0; d0 < 4; ++d0) qr[d0] = *(const GAS bf16x8*)(qrow + d0 * 16); }
        asm volatile("s_waitcnt vmcnt(0)" ::: "memory");
#pragma unroll
        for (int d0 = 0; d0 < 4; ++d0) o[d0] = (f32x16){};
        float m_reg = -1e30f, l_reg = 0.f;
        DA_DMA_K(0, 0); DA_DMA_V(0, 0); DA_DMA_K(1, 1); DA_DMA_V(1, 1);
        int s3 = 0;
#pragma unroll 1
        for (int j = 0; j < NT; ++j) {
            const int sp = (s3 == 0) ? 2 : s3 - 1; const int tn = (j + 2 < NT) ? j + 2 : NT - 1;
            DA_WAIT_BAR(3);
            DA_DMA_K(tn, sp); DA_DMA_V(tn, sp);
            f32x16 p0, p1; bf16x8 pf[4];
            qkt(p0, p1, kp0 + s3 * KSLOT, qr);
            const float al = softmax_tile(p0, p1, m_reg, l_reg, pf);
            if (__any(al < 1.f)) {
#pragma unroll
                for (int d_ = 0; d_ < 4; ++d_) o[d_] = o[d_] * al; }
            pv(o, vp0 + s3 * VSLOT, pf);
            s3 = (s3 == 2) ? 0 : s3 + 1;
        }
        DA_WAIT_BAR(0);
        { auto rr = __builtin_amdgcn_permlane32_swap(__float_as_uint(l_reg), __float_as_uint(l_reg), false, false); l_reg = __uint_as_float(rr[0]) + __uint_as_float(rr[1]); }
        const float il = 1.f / l_reg;
        int tide = tid; asm volatile("" : "+v"(tide));
        const int lanee = tide & 63, hie = (tide >> 5) & 1;
        GAS f32x4* stash = (GAS f32x4*)(A.ws + WS_O1) + (size_t)unit * 16 * NTHR + tide;
        if (map == 0) {
#pragma unroll
            for (int d0 = 0; d0 < 4; ++d0)
#pragma unroll
                for (int g = 0; g < 4; ++g) stash[(size_t)(d0 * 4 + g) * NTHR] = (f32x4){o[d0][4 * g] * il, o[d0][4 * g + 1] * il, o[d0][4 * g + 2] * il, o[d0][4 * g + 3] * il};
        } else {
            const float lam = __expf(wave_sum(A.lq1[lanee] * A.lk1[lanee])) - __expf(wave_sum(A.lq2[lanee] * A.lk2[lanee])) + LAMBDA_INIT;
            const float c2 = lam * il; float ss = 0.f;
#pragma unroll
            for (int d0 = 0; d0 < 4; ++d0)
#pragma unroll
                for (int g = 0; g < 4; ++g) { const f32x4 o1 = stash[(size_t)(d0 * 4 + g) * NTHR];
#pragma unroll
                    for (int e = 0; e < 4; ++e) { const float v = o1[e] - c2 * o[d0][4 * g + e]; o[d0][4 * g + e] = v; ss += v * v; } }
            { auto rr = __builtin_amdgcn_permlane32_swap(__float_as_uint(ss), __float_as_uint(ss), false, false); ss = __uint_as_float(rr[0]) + __uint_as_float(rr[1]); }
            const float rs = (1.f - LAMBDA_INIT) / sqrtf(ss * (1.f / 128.f) + LN_EPS);
            bf16* crow_p = (bf16*)(A.ws + WS_CAT) + ((size_t)b * SEQ + qb * 256 + wid * 32 + (lanee & 31)) * DM + 512 + h * 128 + 4 * hie;
#pragma unroll
            for (int d0 = 0; d0 < 4; ++d0)
#pragma unroll
                for (int g = 0; g < 4; ++g) { const int d = 32 * d0 + 8 * g; const f32x4 gg = *(const f32x4*)(A.subln_g + d + 4 * hie);
                    *(GAS v2u*)(crow_p + d) = (v2u){pk2(o[d0][4 * g] * rs * gg.x, o[d0][4 * g + 1] * rs * gg.y), pk2(o[d0][4 * g + 2] * rs * gg.z, o[d0][4 * g + 3] * rs * gg.w)}; }
        }
#undef DA_DMA_K
#undef DA_DMA_V
    }
}
}

__global__ void __launch_bounds__(NTHR, 2) fwd_kernel(Args A) {
    extern __shared__ __attribute__((aligned(16))) unsigned char lds_raw[];
    LAS unsigned char* lds = (LAS unsigned char*)lds_raw;
    const int tid = threadIdx.x, lane = tid & 63, wave = __builtin_amdgcn_readfirstlane(tid >> 6);
    const int G = gridDim.x; const int bx = blockIdx.x; const int vcu = (G % 8 == 0) ? (bx % 8) * (G / 8) + bx / 8 : bx;
    const int gw = vcu * NWAVES + wave, NGW = G * NWAVES;
    volatile LAS unsigned* MISC = (volatile LAS unsigned*)(lds + MISC_OFF);
    for (int u = tid; u < (LDS_BYTES - LDSCTL_OFF) / 4; u += NTHR) ((LAS unsigned*)(lds + LDSCTL_OFF))[u] = 0u;
    __syncthreads();
    unsigned* barw = (unsigned*)(A.ws + WS_CTL) + CW_BAR;
    XcdBarrier bar; bar.bar = barw; bar.x = 0; bar.st = nullptr;
    const int lo = A.ph_lo, hi = A.ph_hi;
    if (hi - lo > 1) bar = xcd_barrier_post(barw, MISC + 8);
#define IN(k) (lo <= (k) && (k) < hi)
#define SEAM(k) do { if (IN(k) && IN((k) + 1)) xcd_barrier(bar); } while (0)
    unsigned char* ws = A.ws;
    const float* mod = (const float*)(ws + WS_MOD);

    if (IN(0)) { p0_prologue(A, lds, tid, lane, wave, vcu, G); }
    SEAM(0);
    if (IN(1)) { p1_ln_mod(A, lane, gw, NGW); }
    SEAM(1);
    if (IN(2)) {
        pg8::Gemm g{(const bf16*)(ws + WS_XN), (const bf16*)(ws + WS_WIN), M, INC, DM}; pg8::StaticOrder S; S.init(M, INC, G, bx);
        pg8::EpiFn<FProj> E{FProj{ws}};
        pg8::gemm_phase<pg8::EpiFn<FProj>, pg8::StaticOrder, true, true>(lds, g, S, E);
    }
    SEAM(2);
    if (IN(3)) { na_simple(A, vcu * NTHR + tid, G * NTHR); __syncthreads(); for (int u = vcu; u < 256; u += G) da::da_unit(A, lds, u, tid, lane, wave); }
    SEAM(3);
    if (IN(4)) {
        pg8::Gemm g{(const bf16*)(ws + WS_CAT), (const bf16*)(ws + WS_WOUT), M, DM, DM}; pg8::StaticOrder S; S.init(M, DM, G, bx);
        pg8::EpiFn<FRes> E{FRes{A.x, A.out, mod + 2048}};
        pg8::gemm_phase<pg8::EpiFn<FRes>, pg8::StaticOrder, true, true>(lds, g, S, E);
    }
    SEAM(4);
    if (IN(5)) { ln_affine_pass<true>(A, A.ln1_g, A.ln1_b, lane, gw, NGW); }
    SEAM(5);
    if (IN(6)) {
        pg8::Gemm g{(const bf16*)(ws + WS_XN), (const bf16*)(ws + WS_WGU), M, NGU, DM}; pg8::StaticOrder S; S.init(M, NGU, G, bx);
        pg8::EpiFn<FGU> E{FGU{(bf16*)(ws + WS_H)}};
        pg8::gemm_phase<pg8::EpiFn<FGU>, pg8::StaticOrder, true, true>(lds, g, S, E);
    }
    SEAM(6);
    if (IN(7)) {
        pg8::Gemm g{(const bf16*)(ws + WS_H), (const bf16*)(ws + WS_WD), M, DM, DFF}; pg8::StaticOrder S; S.init(M, DM, G, bx);
        pg8::EpiFn<FRes> E{FRes{A.out, A.out, mod + 5120}};
        pg8::gemm_phase<pg8::EpiFn<FRes>, pg8::StaticOrder, true, true>(lds, g, S, E);
    }
    SEAM(7);
    if (IN(8)) { ln_affine_pass<false>(A, A.ln2_g, A.ln2_b, lane, gw, NGW); }
#undef IN
#undef SEAM
}

extern "C" void kernel_launch(void* const* d_in, const int* in_sizes, int n_in, void* d_out, int out_size, void* d_ws, size_t ws_size, hipStream_t stream) {
    static int grid = 0;
    if (grid == 0) {
        if (n_in != 19 || in_sizes[0] != M * DM || out_size != M * DM || ws_size < WS_END) { fprintf(stderr, "kernel_launch: unexpected shapes (n_in %d, in0 %d, out %d, ws %zu)\n", n_in, n_in > 0 ? in_sizes[0] : -1, out_size, ws_size); grid = -1; return; }
        int dev = 0, cus = 0, per_cu = 0;
        if (hipGetDevice(&dev) != hipSuccess || hipDeviceGetAttribute(&cus, hipDeviceAttributeMultiprocessorCount, dev) != hipSuccess) { grid = -1; return; }
        if (hipFuncSetAttribute((const void*)fwd_kernel, hipFuncAttributeMaxDynamicSharedMemorySize, LDS_BYTES) != hipSuccess) { fprintf(stderr, "kernel_launch: hipFuncSetAttribute failed\n"); grid = -1; return; }
        if (hipOccupancyMaxActiveBlocksPerMultiprocessor(&per_cu, (const void*)fwd_kernel, NTHR, LDS_BYTES) != hipSuccess || per_cu < 1) { fprintf(stderr, "kernel_launch: occupancy query says %d blocks/CU\n", per_cu); (void)hipGetLastError(); grid = -1; return; }
        grid = cus;
    }
    if (grid < 0) return;
    Args a{};
    a.x = (const float*)d_in[0]; a.c = (const float*)d_in[1]; a.w_ada = (const float*)d_in[2]; a.b_ada = (const float*)d_in[3]; a.w_in = (const float*)d_in[4]; a.rpb = (const float*)d_in[5];
    a.lq1 = (const float*)d_in[6]; a.lk1 = (const float*)d_in[7]; a.lq2 = (const float*)d_in[8]; a.lk2 = (const float*)d_in[9]; a.subln_g = (const float*)d_in[10]; a.w_out = (const float*)d_in[11];
    a.ln1_g = (const float*)d_in[12]; a.ln1_b = (const float*)d_in[13]; a.w_gate = (const float*)d_in[14]; a.w_up = (const float*)d_in[15]; a.w_down = (const float*)d_in[16]; a.ln2_g = (const float*)d_in[17]; a.ln2_b = (const float*)d_in[18];
    a.out = (float*)d_out; a.ws = (unsigned char*)d_ws;
    for (int i = 0; i < 32; ++i) a.freq[i] = 1.0f / powf(10000.0f, (float)i / 32.0f);
    if (MK_N_LAUNCHES == 1) {
        if (hipMemsetAsync((char*)d_ws + WS_CTL, 0, CTL_ZERO_BYTES, stream) != hipSuccess) return;
        a.ph_lo = 0; a.ph_hi = N_PHASES;
        hipLaunchKernelGGL(fwd_kernel, dim3(grid), dim3(NTHR), LDS_BYTES, stream, a);
    } else {
        for (int p = 0; p < N_PHASES; ++p) { a.ph_lo = p; a.ph_hi = p + 1; hipLaunchKernelGGL(fwd_kernel, dim3(grid), dim3(NTHR), LDS_BYTES, stream, a); }
    }
    const hipError_t le = hipPeekAtLastError();
    if (le != hipSuccess) fprintf(stderr, "kernel_launch: launch failed: %s\n", hipGetErrorName(le));
}
```

```cpp
#include <hip/hip_runtime.h>
#include <cstdio>
#include <cstdint>
#include <cmath>

#ifndef MK_N_LAUNCHES
#define MK_N_LAUNCHES 1
#endif

constexpr int BATCH = 2, SEQ = 8192, DM = 1024, M = BATCH * SEQ;
constexpr int GRID_W = 64, NA_HEADS = 8, HD = 64, NA_KR = 8, NA_KC = 16, ROWS = SEQ / GRID_W;
constexpr int DA_HEADS = 4, DA_V = 128;
constexpr int INC = 3072, DFF = 2816, NGU = 2 * DFF;
constexpr int O_NAQ = 0, O_NAK = 512, O_NAV = 1024, O_DAQ = 1536, O_DAK = 2048, O_DAV = 2560;
constexpr float LN_EPS = 1e-5f;
constexpr float ALPHA = 1.189207115002721f;
constexpr float LAMBDA_INIT = 0.2f;
constexpr float C2 = 0.125f * 1.4426950408889634f;

namespace pg8 {
#define PG8_LAS __attribute__((address_space(3)))
typedef unsigned short bf16_t;
typedef short bf16x8 __attribute__((ext_vector_type(8)));
typedef float f32x4 __attribute__((ext_vector_type(4)));
typedef unsigned u32x4 __attribute__((ext_vector_type(4)));
constexpr int BM = 256, BK = 64, HALF = 128, HTB = HALF * BK * 2, STAGE_BYTES = 8 * HTB, NXCD = 8, WGM = 8;

__host__ __device__ __forceinline__ int lds_byte(int r, int c) { const int st = (r >> 4) * 2 + (c >> 5), rr = r & 15, cc = c & 31, ob = rr * 64 + cc * 2; return st * 1024 + (ob ^ (((ob >> 9) & 1) << 5)); }
__host__ __device__ __forceinline__ void stage_rc(int b, int& R, int& C) { const int st = b / 1024, sb = b % 1024, swz = sb ^ (((sb >> 9) & 1) << 5); R = (st >> 1) * 16 + swz / 64; C = (st & 1) * 32 + (swz % 64) / 2; }
__host__ __device__ __forceinline__ int perm32(int rho) { const int n = rho >> 4, i = rho & 15; return 8 * (i >> 2) + 4 * n + (i & 3); }

struct Unit { int pm, pn; };
struct Gemm { const bf16_t* A; const bf16_t* Bt; int M, N, K; };

struct StaticOrder {
    int nM, nN, nwg, G, c;
    __host__ __device__ void init(int M_, int N_, int G_, int c_) { nM = M_ / BM; nN = N_ / BM; nwg = nM * nN; G = G_; c = c_; }
    __host__ __device__ bool next(int i, Unit& u) const {
        const long L = (long)i * G + c; if (L >= nwg) return false;
        int wgid = (int)L; { const int q = nwg / NXCD, r = nwg % NXCD, xcd = wgid % NXCD, off = wgid / NXCD; wgid = (xcd < r ? xcd * (q + 1) : r * (q + 1) + (xcd - r) * q) + off; }
        const int nig = WGM * nN, gid = wgid / nig, fm = gid * WGM, gsz = (nM - fm) < WGM ? (nM - fm) : WGM;
        u.pm = fm + ((wgid % nig) % gsz); u.pn = (wgid % nig) / gsz; return true;
    }
    __device__ __forceinline__ void a_ready(const Unit&) const {}
    __device__ __forceinline__ void done(const Unit&) const {}
};

template <class F> struct EpiFn {
    static constexpr bool PERM = false, AFTER_DRAIN = false; F f;
    __device__ __forceinline__ void operator()(const f32x4 (&acc)[2][2][4][2], const Unit& u, int wr, int wc, int fr, int fq) const {
        asm volatile("" : "+v"(fr), "+v"(fq));
#pragma unroll
        for (int ai = 0; ai < 2; ++ai)
#pragma unroll
            for (int m = 0; m < 4; ++m) { const int row = u.pm * BM + ai * HALF + wr * 64 + m * 16 + fr;
#pragma unroll
                for (int bj = 0; bj < 2; ++bj)
#pragma unroll
                    for (int n = 0; n < 2; ++n) f(row, u.pn * BM + bj * HALF + wc * 32 + n * 16 + 4 * fq, acc[ai][bj][m][n], u.pn); }
    }
    __device__ __forceinline__ void fused(f32x4 (&)[2][2][4][2], const Unit&, int, int, int, int, PG8_LAS unsigned char*, int, int) const {}
};

template <class Epi, class Sched, bool ALIGN_EPI = false, bool SP2 = false>
__device__ __forceinline__ void gemm_phase(PG8_LAS unsigned char* lds, const Gemm g, const Sched& S, const Epi& E) {
    const int tid = threadIdx.x, wid = __builtin_amdgcn_readfirstlane(tid >> 6), lane = tid & 63, wr = wid >> 2, wc = wid & 3, fr = lane & 15, fq = lane >> 4;
    const int K = g.K, nt = K / BK;
    unsigned voffA[2], voffB[2];
#pragma unroll
    for (int i = 0; i < 2; ++i) { int R, C; stage_rc(tid * 16 + i * 8192, R, C); const int Rb = Epi::PERM ? ((R & ~31) + perm32(R & 31)) : R;
        voffA[i] = (unsigned)(R * K + C) * 2u; voffB[i] = (unsigned)(Rb * K + C) * 2u; }
    const size_t kstep = (size_t)(BK * 2);
    const size_t hstep = (size_t)HALF * K * 2;
    const size_t tstep = 2 * hstep;
    const unsigned ldsw = (unsigned)wid * 1024u;
    const int aoff = lds_byte(wr * 64 + fr, fq * 8), boff = lds_byte(wc * 32 + fr, fq * 8);
#define PG8_SA(b, h) (((b) * 2 + (h)) * HTB)
#define PG8_SB(b, h) ((4 + (b) * 2 + (h)) * HTB)
#define PG8_STAGE(bufoff, gbase, voff) do { _Pragma("unroll") for (int _i = 0; _i < 2; ++_i) \
        __builtin_amdgcn_global_load_lds((const unsigned*)((const char*)(gbase) + (voff)[_i]), (PG8_LAS unsigned*)(lds + (bufoff) + ldsw + _i * 8192), 16, 0, 0); } while (0)
#define PG8_LDA(dst, b, h) do { _Pragma("unroll") for (int m = 0; m < 4; ++m) _Pragma("unroll") for (int k = 0; k < 2; ++k) dst[m][k] = *(const PG8_LAS bf16x8*)(lds + PG8_SA(b, h) + aoff + m * 2048 + k * 1024); } while (0)
#define PG8_LDB(dst, b, h) do { _Pragma("unroll") for (int n = 0; n < 2; ++n) _Pragma("unroll") for (int k = 0; k < 2; ++k) dst[n][k] = *(const PG8_LAS bf16x8*)(lds + PG8_SB(b, h) + boff + n * 2048 + k * 1024); } while (0)
#define PG8_MMA(ai, bj, At, Bt) do { __builtin_amdgcn_s_setprio(1); _Pragma("unroll") for (int m = 0; m < 4; ++m) _Pragma("unroll") for (int n = 0; n < 2; ++n) _Pragma("unroll") for (int k = 0; k < 2; ++k) \
        acc[ai][bj][m][n] = __builtin_amdgcn_mfma_f32_16x16x32_bf16(Bt[n][k], At[m][k], acc[ai][bj][m][n], 0, 0, 0); __builtin_amdgcn_s_setprio(0); } while (0)
#define PG8_WAIT_V(n) asm volatile("s_waitcnt vmcnt(" #n ")" ::: "memory")
#define PG8_WAIT_L(n) asm volatile("s_waitcnt lgkmcnt(" #n ")" ::: "memory")
#define PG8_BAR __builtin_amdgcn_s_barrier()
#define PG8_SCHED __builtin_amdgcn_sched_barrier(0)
    Unit cur, nxt; int ui = 0;
    if (!S.next(0, cur)) return;
    f32x4 acc[2][2][4][2];
#pragma unroll
    for (int a = 0; a < 2; ++a)
#pragma unroll
        for (int b = 0; b < 2; ++b)
#pragma unroll
            for (int m = 0; m < 4; ++m)
#pragma unroll
                for (int n = 0; n < 2; ++n) acc[a][b][m][n] = (f32x4){0.f, 0.f, 0.f, 0.f};
    bf16x8 At[4][2], B0[2][2], B1[2][2];
    const char* cA = (const char*)g.A + (size_t)cur.pm * tstep; const char* cB = (const char*)g.Bt + (size_t)cur.pn * tstep;
    S.a_ready(cur);
    if constexpr (SP2) {
        PG8_STAGE(PG8_SB(0, 0), cB, voffB); PG8_STAGE(PG8_SB(0, 1), cB + hstep, voffB); PG8_STAGE(PG8_SA(0, 0), cA, voffA); PG8_STAGE(PG8_SA(0, 1), cA + hstep, voffA);
        if (wr == 1) PG8_BAR;
        PG8_WAIT_V(2); PG8_BAR;
        PG8_STAGE(PG8_SB(1, 0), cB + kstep, voffB); PG8_STAGE(PG8_SA(1, 0), cA + kstep, voffA); PG8_STAGE(PG8_SB(1, 1), cB + hstep + kstep, voffB);
        PG8_WAIT_V(6); PG8_BAR;
    } else {
        PG8_STAGE(PG8_SB(0, 0), cB, voffB); PG8_STAGE(PG8_SA(0, 0), cA, voffA); PG8_STAGE(PG8_SB(0, 1), cB + hstep, voffB); PG8_STAGE(PG8_SA(0, 1), cA + hstep, voffA);
        if (wr == 1) PG8_BAR;
        PG8_WAIT_V(4); PG8_BAR;
        PG8_STAGE(PG8_SB(1, 0), cB + kstep, voffB); PG8_STAGE(PG8_SA(1, 0), cA + kstep, voffA); PG8_STAGE(PG8_SB(1, 1), cB + hstep + kstep, voffB);
        PG8_WAIT_V(6); PG8_BAR;
    }
    for (;;) {
        const bool has_next = S.next(ui + 1, nxt);
        const char* nA = has_next ? (const char*)g.A + (size_t)nxt.pm * tstep : cA; const char* nB = has_next ? (const char*)g.Bt + (size_t)nxt.pn * tstep : cB;
        for (int t = 0; t < nt; t += 2) {
            const bool last = (t == nt - 2);
            const char* a1 = cA + (size_t)(t + 1) * kstep;
            const char* a2 = last ? nA : cA + (size_t)(t + 2) * kstep; const char* b2 = last ? nB : cB + (size_t)(t + 2) * kstep;
            const char* a3 = a2 + kstep; const char* b3 = b2 + kstep;
            if (last && has_next) S.a_ready(nxt);
            if constexpr (SP2) {
            PG8_LDB(B0, 0, 0); PG8_LDB(B1, 0, 1); PG8_SCHED; PG8_LDA(At, 0, 0); PG8_STAGE(PG8_SA(1, 1), a1 + hstep, voffA);
            PG8_WAIT_V(8); PG8_WAIT_L(0); PG8_BAR; PG8_MMA(0, 0, At, B0); PG8_MMA(0, 1, At, B1); PG8_BAR; PG8_SCHED;
            PG8_LDA(At, 0, 1); PG8_STAGE(PG8_SB(0, 0), b2, voffB); PG8_STAGE(PG8_SB(0, 1), b2 + hstep, voffB); PG8_STAGE(PG8_SA(0, 0), a2, voffA);
            PG8_WAIT_V(8); PG8_WAIT_L(0); PG8_BAR; PG8_MMA(1, 0, At, B0); PG8_MMA(1, 1, At, B1); PG8_BAR; PG8_SCHED;
            PG8_LDB(B0, 1, 0); PG8_LDB(B1, 1, 1); PG8_SCHED; PG8_LDA(At, 1, 0); PG8_STAGE(PG8_SA(0, 1), a2 + hstep, voffA);
            PG8_WAIT_V(8); PG8_WAIT_L(0); PG8_BAR; PG8_MMA(0, 0, At, B0); PG8_MMA(0, 1, At, B1); PG8_BAR; PG8_SCHED;
            PG8_LDA(At, 1, 1); PG8_STAGE(PG8_SB(1, 0), b3, voffB); PG8_STAGE(PG8_SB(1, 1), b3 + hstep, voffB); PG8_STAGE(PG8_SA(1, 0), a3, voffA);
            PG8_WAIT_V(8); PG8_WAIT_L(0); PG8_BAR; PG8_MMA(1, 0, At, B0); PG8_MMA(1, 1, At, B1); PG8_BAR; PG8_SCHED;
            } else {
            PG8_LDB(B0, 0, 0); PG8_SCHED; PG8_LDA(At, 0, 0); PG8_STAGE(PG8_SA(1, 1), a1 + hstep, voffA);
            PG8_WAIT_L(8); PG8_BAR; PG8_WAIT_L(0); PG8_MMA(0, 0, At, B0); PG8_BAR; PG8_SCHED;
            PG8_LDB(B1, 0, 1); PG8_STAGE(PG8_SB(0, 0), b2, voffB);
            PG8_BAR; PG8_WAIT_L(0); PG8_MMA(0, 1, At, B1); PG8_BAR;
            PG8_LDA(At, 0, 1); PG8_STAGE(PG8_SA(0, 0), a2, voffA);
            PG8_BAR; PG8_WAIT_L(0); PG8_MMA(1, 0, At, B0); PG8_BAR; PG8_SCHED;
            PG8_STAGE(PG8_SB(0, 1), b2 + hstep, voffB);
            PG8_WAIT_V(6); PG8_BAR; PG8_MMA(1, 1, At, B1); PG8_BAR;
            PG8_LDB(B0, 1, 0); PG8_SCHED; PG8_LDA(At, 1, 0); PG8_STAGE(PG8_SA(0, 1), a2 + hstep, voffA);
            PG8_WAIT_L(8); PG8_BAR; PG8_WAIT_L(0); PG8_MMA(0, 0, At, B0); PG8_BAR; PG8_SCHED;
            PG8_LDB(B1, 1, 1); PG8_STAGE(PG8_SB(1, 0), b3, voffB);
            PG8_BAR; PG8_WAIT_L(0); PG8_MMA(0, 1, At, B1); PG8_BAR;
            PG8_LDA(At, 1, 1); PG8_STAGE(PG8_SA(1, 0), a3, voffA);
            PG8_BAR; PG8_WAIT_L(0); PG8_MMA(1, 0, At, B0); PG8_BAR; PG8_SCHED;
            PG8_STAGE(PG8_SB(1, 1), b3 + hstep, voffB);
            PG8_WAIT_V(6); PG8_BAR; PG8_MMA(1, 1, At, B1); PG8_BAR;
            }
        }
        if constexpr (ALIGN_EPI) { if (wr == 0) PG8_BAR; }
        if constexpr (!Epi::AFTER_DRAIN) { E(acc, cur, wr, wc, fr, fq); S.done(cur); }
        if (!has_next) break;
#pragma unroll
        for (int a = 0; a < 2; ++a)
#pragma unroll
            for (int b = 0; b < 2; ++b)
#pragma unroll
                for (int m = 0; m < 4; ++m)
#pragma unroll
                    for (int n = 0; n < 2; ++n) acc[a][b][m][n] = (f32x4){0.f, 0.f, 0.f, 0.f};
        cur = nxt; cA = nA; cB = nB; ++ui;
        if constexpr (ALIGN_EPI) { if (wr == 1) PG8_BAR; }
    }
    PG8_WAIT_V(0);
    if constexpr (!ALIGN_EPI) { if (wr == 0) PG8_BAR; }
    PG8_BAR;
    if constexpr (Epi::AFTER_DRAIN) { E.fused(acc, cur, wr, wc, fr, fq, lds, wid, lane); S.done(cur); }
#undef PG8_SA
#undef PG8_SB
#undef PG8_STAGE
#undef PG8_LDA
#undef PG8_LDB
#undef PG8_MMA
#undef PG8_WAIT_V
#undef PG8_WAIT_L
#undef PG8_BAR
#undef PG8_SCHED
}
}

constexpr int NWAVES = 8, NTHR = NWAVES * 64;
constexpr int N_PHASES = 9;
constexpr size_t MiB = 1u << 20;
constexpr size_t WS_CTL = 0, CTL_ZERO_BYTES = 64 * 1024;
constexpr size_t WS_MOD = 1 * MiB;
constexpr size_t WS_ROPE = 2 * MiB;
constexpr size_t WS_WIN = 4 * MiB;
constexpr size_t WS_WOUT = 10 * MiB;
constexpr size_t WS_WGU = 12 * MiB;
constexpr size_t WS_WD = 23 * MiB;
constexpr size_t WS_XN = 32 * MiB;
constexpr size_t WS_PROJ = 64 * MiB;
constexpr size_t WS_H = WS_PROJ;
constexpr size_t WS_CAT = 160 * MiB;
constexpr size_t WS_DAK = 192 * MiB;
constexpr size_t WS_DAV = 208 * MiB;
constexpr size_t WS_NAVT = 224 * MiB;
constexpr size_t WS_END = 256 * MiB;
constexpr int CW_BAR = 1024;
constexpr int RING_BYTES = 131072, LDSCTL_OFF = RING_BYTES, MISC_OFF = LDSCTL_OFF + 320, LDS_BYTES = 147456;

#define GAS __attribute__((address_space(1)))
#define LAS __attribute__((address_space(3)))
typedef unsigned short bf16;
typedef unsigned v4u __attribute__((ext_vector_type(4)));
typedef unsigned v2u __attribute__((ext_vector_type(2)));
typedef float f32x4 __attribute__((ext_vector_type(4)));
typedef float f32x2 __attribute__((ext_vector_type(2)));
#define LDS_WAIT() asm volatile("s_waitcnt lgkmcnt(0)" ::: "memory")
#define VM_WAIT() asm volatile("s_waitcnt vmcnt(0)" ::: "memory")
__device__ __forceinline__ unsigned f2bf(float f) { unsigned u = __builtin_bit_cast(unsigned, f); return (u + 0x7fffu + ((u >> 16) & 1u)) >> 16; }
__device__ __forceinline__ unsigned pk2(float lo, float hi) { return f2bf(lo) | (f2bf(hi) << 16); }
__device__ __forceinline__ float bflo(unsigned w) { return __builtin_bit_cast(float, w << 16); }
__device__ __forceinline__ float bfhi(unsigned w) { return __builtin_bit_cast(float, w & 0xffff0000u); }
__device__ __forceinline__ float wave_sum(float v) {
#pragma unroll
    for (int o = 1; o < 64; o <<= 1) v += __shfl_xor(v, o);
    return v;
}

#define XB_TMO      128
#define XB_XCNT(j)  (256  + 64 * (j))
#define XB_XSUB(j)  (1280 + 64 * (j))
#define XB_XGEN(j)  (2304 + 64 * (j))
#define XB_TOP      3328
#define XB_TOPGEN   3392
#define XCD_BAR_WORDS 3456
#define XB_SPIN_CAP (1u << 18)
__device__ __forceinline__ unsigned xb_ld(unsigned* p)              { return __hip_atomic_load(p, __ATOMIC_RELAXED, __HIP_MEMORY_SCOPE_AGENT); }
__device__ __forceinline__ unsigned xb_add(unsigned* p, unsigned v) { return __hip_atomic_fetch_add(p, v, __ATOMIC_RELAXED, __HIP_MEMORY_SCOPE_AGENT); }
__device__ __forceinline__ unsigned xb_xcc_id() { return (unsigned)__builtin_amdgcn_s_getreg((3 << 11) | 20) & 0xFu; }
#define XB_SPIN(cond, bar) do { unsigned _sp = 0; while (cond) { __builtin_amdgcn_s_sleep(1); \
    if ((++_sp & 255u) == 0u) { if (xb_ld(&(bar)[XB_TMO])) break; if (_sp > XB_SPIN_CAP) { atomicAdd(&(bar)[XB_TMO], 1u); break; } } } } while (0)
struct XcdBarrier { unsigned* bar; unsigned x; volatile LAS unsigned* st; };
__device__ __forceinline__ XcdBarrier xcd_barrier_post(unsigned* bar, volatile LAS unsigned* st) {
    XcdBarrier b; b.bar = bar; b.x = xb_xcc_id(); b.st = st;
    if (threadIdx.x == 0) (void)xb_add(&bar[XB_XCNT(b.x)], 1u);
    return b;
}
__device__ __forceinline__ void xcd_barrier_complete(unsigned* bar, unsigned x, unsigned& nloc, unsigned& nx) {
    const unsigned G = gridDim.x * gridDim.y * gridDim.z;
    unsigned sum, cnt, mine, sp = 0u;
    for (;;) {
        sum = 0u; cnt = 0u; mine = 0u;
#pragma unroll
        for (unsigned j = 0; j < 16; ++j) { const unsigned c = xb_ld(&bar[XB_XCNT(j)]); sum += c; cnt += (c > 0u) ? 1u : 0u; mine = (j == x) ? c : mine; }
        if (sum == G) break;
        __builtin_amdgcn_s_sleep(1);
        if ((++sp & 255u) == 0u) { if (xb_ld(&bar[XB_TMO])) break; if (sp > XB_SPIN_CAP) { atomicAdd(&bar[XB_TMO], 1u); break; } }
    }
    nloc = mine > 0u ? mine : 1u; nx = cnt > 0u ? cnt : 1u;
}
__device__ __forceinline__ void xcd_barrier(const XcdBarrier& b) {
    asm volatile("s_waitcnt vmcnt(0)" ::: "memory");
    __syncthreads();
    if (threadIdx.x == 0) {
        unsigned* bar = b.bar;
        __builtin_amdgcn_s_waitcnt(0);
        unsigned nloc = b.st[0], nx = b.st[1];
        if (nloc == 0u) { xcd_barrier_complete(bar, b.x, nloc, nx); b.st[0] = nloc; b.st[1] = nx; }
        const unsigned old = xb_add(&bar[XB_XSUB(b.x)], 1u);
        const unsigned gen = old / nloc;
        if (old + 1u == (gen + 1u) * nloc) {
            __builtin_amdgcn_fence(__ATOMIC_RELEASE, "agent");
            asm volatile("s_waitcnt vmcnt(0)" ::: "memory");
            const unsigned og = xb_add(&bar[XB_TOP], 1u);
            const unsigned tg = og / nx;
            if (og + 1u == (tg + 1u) * nx) xb_add(&bar[XB_TOPGEN], 1u);
            else XB_SPIN(xb_ld(&bar[XB_TOPGEN]) == tg, bar);
            __builtin_amdgcn_fence(__ATOMIC_ACQUIRE, "agent");
            xb_add(&bar[XB_XGEN(b.x)], 1u);
            asm volatile("s_waitcnt vmcnt(0)" ::: "memory");
        } else {
            XB_SPIN(xb_ld(&bar[XB_XGEN(b.x)]) == gen, bar);
            __builtin_amdgcn_fence(__ATOMIC_ACQUIRE, "agent");
            asm volatile("s_waitcnt vmcnt(0)" ::: "memory");
        }
    }
    __syncthreads();
}

struct Args {
    const float* x; const float* c; const float* w_ada; const float* b_ada; const float* w_in; const float* rpb;
    const float* lq1; const float* lk1; const float* lq2; const float* lk2; const float* subln_g; const float* w_out;
    const float* ln1_g; const float* ln1_b; const float* w_gate; const float* w_up; const float* w_down; const float* ln2_g; const float* ln2_b;
    float* out; unsigned char* ws; int ph_lo, ph_hi; float freq[32];
};

__device__ __forceinline__ int dst_row(int mat, int n) {
    if (mat == 0) { if (n < O_DAQ || n >= O_DAV) return n; const int d = n & 63; return (n & ~63) + (d < 32 ? 2 * d : 2 * (d - 32) + 1); }
    if (mat == 2) return 2 * n;
    if (mat == 3) return 2 * n + 1;
    return n;
}
__device__ __forceinline__ void p0_transpose_item(const float* W, int K, int N, bf16* WT, int mat, LAS float* scr, int item, int lane) {
    const int nblk = N / 32, kb = item / nblk, nb = item % nblk, k0 = 64 * kb, n0 = 32 * nb;
#pragma unroll 8
    for (int i = 0; i < 32; ++i) { const int kk = 2 * i + (lane >> 5); scr[kk * 33 + (lane & 31)] = W[(size_t)(k0 + kk) * N + n0 + (lane & 31)]; }
    LDS_WAIT(); asm volatile("" ::: "memory");
    const int c = lane & 7;
#pragma unroll
    for (int j = 0; j < 4; ++j) { const int n = (lane >> 3) + 8 * j; const LAS float* s = scr + (8 * c) * 33 + n;
        v4u o; o.x = pk2(s[0 * 33], s[1 * 33]); o.y = pk2(s[2 * 33], s[3 * 33]); o.z = pk2(s[4 * 33], s[5 * 33]); o.w = pk2(s[6 * 33], s[7 * 33]);
        *(GAS v4u*)(WT + (size_t)dst_row(mat, n0 + n) * K + k0 + 8 * c) = o; }
    LDS_WAIT(); asm volatile("" ::: "memory");
}
__device__ __forceinline__ void sincos_d(double a, float& co, float& si) {
    const double k = __builtin_rint(a * 0.63661977236758134308);
    const double r = __builtin_fma(-k, 1.57079632679489661923, a) - k * 6.123233995736766e-17;
    const double r2 = r * r;
    double s = -2.5052108385441718775e-8; s = s * r2 + 2.7557319223985890653e-6; s = s * r2 - 1.9841269841269841270e-4; s = s * r2 + 8.3333333333333333333e-3; s = s * r2 - 1.6666666666666666667e-1; s = s * r2 * r + r;
    double c = 2.0876756987868098979e-9; c = c * r2 - 2.7557319223985890653e-7; c = c * r2 + 2.4801587301587301587e-5; c = c * r2 - 1.3888888888888888889e-3; c = c * r2 + 4.1666666666666666667e-2; c = c * r2 - 0.5; c = c * r2 + 1.0;
    const int q = (int)((long long)k & 3);
    const double cc = (q == 0) ? c : (q == 1) ? -s : (q == 2) ? -c : s;
    const double ss = (q == 0) ? s : (q == 1) ? c : (q == 2) ? -s : -c;
    co = (float)cc; si = (float)ss;
}
__device__ __forceinline__ void p0_prologue(const Args& A, LAS unsigned char* lds, int tid, int lane, int wave, int vcu, int G) {
    unsigned char* ws = A.ws;
    { LAS float* part = (LAS float*)lds;
      float* mod = (float*)(ws + WS_MOD);
      for (int it = vcu; it < 6144 / 32; it += G) {
          const int col = tid & 31, ks = tid >> 5, j = it * 32 + col; float a0 = 0.f, a1 = 0.f;
#pragma unroll 8
          for (int k = ks * 64; k < ks * 64 + 64; ++k) { const float w = A.w_ada[(size_t)k * 6144 + j]; const float c0 = A.c[k], c1 = A.c[1024 + k];
              a0 += (c0 / (1.f + __expf(-c0))) * w; a1 += (c1 / (1.f + __expf(-c1))) * w; }
          part[(0 * 16 + ks) * 32 + col] = a0; part[(1 * 16 + ks) * 32 + col] = a1;
          __syncthreads();
          if (tid < 64) { const int b = tid >> 5, cc = tid & 31; float s = A.b_ada[it * 32 + cc];
#pragma unroll
              for (int q = 0; q < 16; ++q) s += part[(b * 16 + q) * 32 + cc];
              mod[b * 6144 + it * 32 + cc] = s; }
          __syncthreads();
      } }
    { f32x2* tab = (f32x2*)(ws + WS_ROPE);
      for (int e = vcu * NTHR + tid; e < SEQ * 32; e += G * NTHR) { const int pos = e >> 5, i = e & 31; const float ang = (float)pos * A.freq[i]; float co, si; sincos_d((double)ang, co, si); tab[e] = (f32x2){co, si}; } }
    { LAS float* scr = (LAS float*)(lds + wave * 16384);
      const int gw = vcu * NWAVES + wave, NGW = G * NWAVES;
      constexpr int I_IN = (DM / 64) * (INC / 32), I_OUT = (DM / 64) * (DM / 32), I_G = (DM / 64) * (DFF / 32), I_D = (DFF / 64) * (DM / 32);
      constexpr int NITEMS = I_IN + I_OUT + 2 * I_G + I_D;
      for (int it = gw; it < NITEMS; it += NGW) {
          int r = it;
          if (r < I_IN) { p0_transpose_item(A.w_in, DM, INC, (bf16*)(ws + WS_WIN), 0, scr, r, lane); continue; } r -= I_IN;
          if (r < I_OUT) { p0_transpose_item(A.w_out, DM, DM, (bf16*)(ws + WS_WOUT), 1, scr, r, lane); continue; } r -= I_OUT;
          if (r < I_G) { p0_transpose_item(A.w_gate, DM, DFF, (bf16*)(ws + WS_WGU), 2, scr, r, lane); continue; } r -= I_G;
          if (r < I_G) { p0_transpose_item(A.w_up, DM, DFF, (bf16*)(ws + WS_WGU), 3, scr, r, lane); continue; } r -= I_G;
          p0_transpose_item(A.w_down, DFF, DM, (bf16*)(ws + WS_WD), 4, scr, r, lane);
      } }
}

__device__ __forceinline__ void p1_ln_mod(const Args& A, int lane, int gw, int NGW) {
    const float* mod = (const float*)(A.ws + WS_MOD); bf16* XN = (bf16*)(A.ws + WS_XN);
    for (int m = gw; m < M; m += NGW) {
        const int b = m / SEQ; const float* sh = mod + b * 6144, *sc = sh + 1024;
        const GAS f32x4* xr = (const GAS f32x4*)(A.x + (size_t)m * DM) + lane;
        f32x4 v[4]; float s = 0.f;
#pragma unroll
        for (int j = 0; j < 4; ++j) { v[j] = xr[64 * j]; s += (v[j].x + v[j].y) + (v[j].z + v[j].w); }
        const float mean = wave_sum(s) * (1.f / DM); float s2 = 0.f;
#pragma unroll
        for (int j = 0; j < 4; ++j) { v[j] = v[j] - mean; s2 += (v[j].x * v[j].x + v[j].y * v[j].y) + (v[j].z * v[j].z + v[j].w * v[j].w); }
        const float rstd = 1.f / sqrtf(wave_sum(s2) * (1.f / DM) + LN_EPS);
        GAS v2u* o8 = (GAS v2u*)(XN + (size_t)m * DM) + lane;
#pragma unroll
        for (int j = 0; j < 4; ++j) { const f32x4 a = *(const f32x4*)(sc + 4 * lane + 256 * j), d = *(const f32x4*)(sh + 4 * lane + 256 * j);
            const f32x4 y = v[j] * rstd * (a + 1.f) + d; o8[64 * j] = (v2u){pk2(y.x, y.y), pk2(y.z, y.w)}; }
    }
}
template <bool XN2> __device__ __forceinline__ void ln_affine_pass(const Args& A, const float* g, const float* bb, int lane, int gw, int NGW) {
    const float* mod = (const float*)(A.ws + WS_MOD); bf16* XN = (bf16*)(A.ws + WS_XN);
    for (int m = gw; m < M; m += NGW) {
        GAS f32x4* yr = (GAS f32x4*)(A.out + (size_t)m * DM) + lane;
        f32x4 v[4]; float s = 0.f;
#pragma unroll
        for (int j = 0; j < 4; ++j) { v[j] = yr[64 * j]; s += (v[j].x + v[j].y) + (v[j].z + v[j].w); }
        const float mean = wave_sum(s) * (1.f / DM); float s2 = 0.f;
#pragma unroll
        for (int j = 0; j < 4; ++j) { v[j] = v[j] - mean; s2 += (v[j].x * v[j].x + v[j].y * v[j].y) + (v[j].z * v[j].z + v[j].w * v[j].w); }
        const float rstd = 1.f / sqrtf(wave_sum(s2) * (1.f / DM) + LN_EPS);
        float t = 0.f;
#pragma unroll
        for (int j = 0; j < 4; ++j) { const f32x4 gg = *(const f32x4*)(g + 4 * lane + 256 * j), be = *(const f32x4*)(bb + 4 * lane + 256 * j);
            v[j] = v[j] * rstd * gg + be; yr[64 * j] = v[j]; t += (v[j].x + v[j].y) + (v[j].z + v[j].w); }
        if constexpr (XN2) {
            const int b = m / SEQ; const float* sh = mod + b * 6144 + 3072, *sc = sh + 1024;
            const float mean2 = wave_sum(t) * (1.f / DM); float t2 = 0.f;
#pragma unroll
            for (int j = 0; j < 4; ++j) { v[j] = v[j] - mean2; t2 += (v[j].x * v[j].x + v[j].y * v[j].y) + (v[j].z * v[j].z + v[j].w * v[j].w); }
            const float rstd2 = 1.f / sqrtf(wave_sum(t2) * (1.f / DM) + LN_EPS);
            GAS v2u* o8 = (GAS v2u*)(XN + (size_t)m * DM) + lane;
#pragma unroll
            for (int j = 0; j < 4; ++j) { const f32x4 a = *(const f32x4*)(sc + 4 * lane + 256 * j), d = *(const f32x4*)(sh + 4 * lane + 256 * j);
                const f32x4 y = v[j] * rstd2 * (a + 1.f) + d; o8[64 * j] = (v2u){pk2(y.x, y.y), pk2(y.z, y.w)}; }
        }
    }
}

struct FProj {
    unsigned char* wsb;
    __device__ __forceinline__ void operator()(int row, int col, f32x4 v, int pn) const {
        bf16* P = (bf16*)(wsb + WS_PROJ); const f32x2* tab = (const f32x2*)(wsb + WS_ROPE); unsigned char* kimg = wsb + WS_DAK; unsigned char* vimg = wsb + WS_DAV;
        if (pn >= 6 && pn < 10) {
            const int pos = row & (SEQ - 1), i = (col & 63) >> 1; const f32x2 c0 = tab[pos * 32 + i], c1 = tab[pos * 32 + i + 1];
            const float sc = (pn < 8) ? C2 : 1.f;
            const float a0 = (v.x * c0.x - v.y * c0.y) * sc, b0 = (v.y * c0.x + v.x * c0.y) * sc, a1 = (v.z * c1.x - v.w * c1.y) * sc, b1 = (v.w * c1.x + v.z * c1.y) * sc;
            v = (f32x4){a0, b0, a1, b1};
        }
        const v2u w = (v2u){pk2(v.x, v.y), pk2(v.z, v.w)};
        if (pn == 4 || pn == 5) { const int b = row / SEQ, s = row & (SEQ - 1), cc = col - O_NAV;
            bf16* vt = (bf16*)(wsb + WS_NAVT) + ((size_t)(b * 512 + cc)) * SEQ + s;
            vt[0] = (bf16)(w.x & 0xffffu); vt[SEQ] = (bf16)(w.x >> 16); vt[2 * SEQ] = (bf16)(w.y & 0xffffu); vt[3 * SEQ] = (bf16)(w.y >> 16); }
        else if (pn < 8) { *(GAS v2u*)(P + (size_t)row * INC + col) = w; }
        else {
            const int b = row / SEQ, s = row & (SEQ - 1), tile = s >> 6, k = s & 63;
            if (pn < 10) { const int cc = col - O_DAK, hm = cc >> 6, slot = cc & 63;
                *(GAS v2u*)(kimg + ((size_t)((b * 8 + hm) * 128 + tile)) * 8192 + (slot >> 3) * 1024 + k * 16 + (slot & 7) * 2) = w; }
            else { const int cc = col - O_DAV, h = cc >> 7, d = cc & 127;
                *(GAS v2u*)(vimg + ((size_t)((b * 4 + h) * 128 + tile)) * 16384 + ((k >> 3) * 4 + (d >> 5)) * 512 + (k & 7) * 64 + (d & 31) * 2) = w; }
        }
    }
};
struct FRes {
    const float* R; float* Y; const float* gate;
    __device__ __forceinline__ void operator()(int row, int col, f32x4 v, int) const {
        const int b = row / SEQ; const f32x4 r = *(const GAS f32x4*)(R + (size_t)row * DM + col), g = *(const f32x4*)(gate + b * 6144 + col);
        *(GAS f32x4*)(Y + (size_t)row * DM + col) = r * ALPHA + (g + 1.f) * v;
    }
};
struct FGU {
    bf16* H;
    __device__ __forceinline__ void operator()(int row, int col, f32x4 v, int) const {
        const float h0 = v.x / (1.f + __expf(-v.x)) * v.y, h1 = v.z / (1.f + __expf(-v.z)) * v.w;
        *(GAS unsigned*)(H + (size_t)row * DFF + (col >> 1)) = pk2(h0, h1);
    }
};

namespace na {
typedef short bf16x8 __attribute__((ext_vector_type(8)));
typedef __bf16 bf16x2_t __attribute__((ext_vector_type(2)));
__device__ __forceinline__ unsigned cvtpk(float lo, float hi) { f32x2 v = {lo, hi}; bf16x2_t b = __builtin_convertvector(v, bf16x2_t); return __builtin_bit_cast(unsigned, b); }
__device__ __forceinline__ void na_item(const Args& A, int b, int r, int h, int i, int lane) {
    const bf16* P = (const bf16*)(A.ws + WS_PROJ); const bf16* VT = (const bf16*)(A.ws + WS_NAVT);
    const int qq = lane & 15, g = lane >> 4, c = 16 * i + qq;
    int rs = r - NA_KR / 2; rs = rs < 0 ? 0 : (rs > ROWS - NA_KR ? ROWS - NA_KR : rs);
    int cs = c - NA_KC / 2; cs = cs < 0 ? 0 : (cs > GRID_W - NA_KC ? GRID_W - NA_KC : cs);
    int tcs = 16 * i - 8; tcs = tcs < 0 ? 0 : (tcs > 32 ? 32 : tcs);
    const size_t tok0 = (size_t)b * SEQ;
    const bf16* qrow = P + (tok0 + r * GRID_W + c) * INC + O_NAQ + h * 64 + 8 * g;
    const bf16x8 q0 = *(const GAS bf16x8*)(qrow), q1 = *(const GAS bf16x8*)(qrow + 32);
    f32x4 sc[8][2];
    const int kcol = tcs + 8 * (qq >> 2) + (qq & 3);
#pragma unroll
    for (int kr = 0; kr < 8; ++kr)
#pragma unroll
        for (int t = 0; t < 2; ++t) {
            const bf16* krow = P + (tok0 + (rs + kr) * GRID_W + kcol + 4 * t) * INC + O_NAK + h * 64 + 8 * g;
            const bf16x8 k0 = *(const GAS bf16x8*)(krow), k1 = *(const GAS bf16x8*)(krow + 32);
            f32x4 acc = (f32x4){0.f, 0.f, 0.f, 0.f};
            acc = __builtin_amdgcn_mfma_f32_16x16x32_bf16(k0, q0, acc, 0, 0, 0);
            acc = __builtin_amdgcn_mfma_f32_16x16x32_bf16(k1, q1, acc, 0, 0, 0);
            sc[kr][t] = acc; }
    const float* rpb = A.rpb + h * 15 * 31;
    float mx = -INFINITY;
#pragma unroll
    for (int kr = 0; kr < 8; ++kr)
#pragma unroll
        for (int t = 0; t < 2; ++t)
#pragma unroll
            for (int e = 0; e < 4; ++e) { const int kc = tcs + 8 * g + 4 * t + e; const bool valid = (kc >= cs) && (kc <= cs + NA_KC - 1);
                const int bi = valid ? (rs + kr - r + NA_KR - 1) * 31 + (kc - c + NA_KC - 1) : 0;
                const float s = valid ? sc[kr][t][e] * C2 + rpb[bi] * 1.4426950408889634f : -INFINITY;
                sc[kr][t][e] = s; mx = fmaxf(mx, s); }
    mx = fmaxf(mx, __shfl_xor(mx, 16)); mx = fmaxf(mx, __shfl_xor(mx, 32));
    float l = 0.f;
#pragma unroll
    for (int kr = 0; kr < 8; ++kr)
#pragma unroll
        for (int t = 0; t < 2; ++t)
#pragma unroll
            for (int e = 0; e < 4; ++e) { const float p = __builtin_amdgcn_exp2f(sc[kr][t][e] - mx); sc[kr][t][e] = p; l += p; }
    l += __shfl_xor(l, 16); l += __shfl_xor(l, 32);
    f32x4 o[4];
#pragma unroll
    for (int d = 0; d < 4; ++d) o[d] = (f32x4){0.f, 0.f, 0.f, 0.f};
    const bf16* vbase = VT + ((size_t)(b * 512 + h * 64 + qq)) * SEQ + rs * GRID_W + tcs + 8 * g;
#pragma unroll
    for (int kr = 0; kr < 8; ++kr) {
        const v4u w = {cvtpk(sc[kr][0][0], sc[kr][0][1]), cvtpk(sc[kr][0][2], sc[kr][0][3]), cvtpk(sc[kr][1][0], sc[kr][1][1]), cvtpk(sc[kr][1][2], sc[kr][1][3])};
        const bf16x8 pb = __builtin_bit_cast(bf16x8, w);
#pragma unroll
        for (int d = 0; d < 4; ++d) { const bf16x8 va = *(const GAS bf16x8*)(vbase + (size_t)(16 * d) * SEQ + kr * GRID_W);
            o[d] = __builtin_amdgcn_mfma_f32_16x16x32_bf16(va, pb, o[d], 0, 0, 0); } }
    const float il = 1.f / l;
    bf16* orow = (bf16*)(A.ws + WS_CAT) + (tok0 + r * GRID_W + c) * DM + h * 64 + 4 * g;
#pragma unroll
    for (int d = 0; d < 4; ++d) *(GAS v2u*)(orow + 16 * d) = (v2u){cvtpk(o[d].x * il, o[d].y * il), cvtpk(o[d].z * il, o[d].w * il)};
}
__device__ __forceinline__ void na_phase(const Args& A, int lane, int wave, int vcu, int G) {
    for (int w = vcu; w < BATCH * ROWS * 4; w += G) { const int b = w >> 9, r = (w >> 2) & 127, hp = w & 3; na_item(A, b, r, 2 * hp + (wave >> 2), wave & 3, lane); }
}
}

namespace da {
typedef short bf16x8 __attribute__((ext_vector_type(8)));
typedef short s16x4 __attribute__((ext_vector_type(4)));
typedef float f32x16 __attribute__((ext_vector_type(16)));
typedef __bf16 bf16x2_t __attribute__((ext_vector_type(2)));
constexpr int KSLOT = 8192, VSLOT = 16384, LDS_K = 0, LDS_V = 3 * KSLOT, NT = SEQ / 64;
constexpr float THRL = 8.f;
__device__ __forceinline__ unsigned cvtpk(float lo, float hi) { f32x2 v = {lo, hi}; bf16x2_t b = __builtin_convertvector(v, bf16x2_t); return __builtin_bit_cast(unsigned, b); }
__device__ __forceinline__ s16x4 vtr(const LAS unsigned char* p) { return __builtin_bit_cast(s16x4, __builtin_amdgcn_ds_read_tr16_b64_v4i16((LAS s16x4*)p)); }
#define DA_WAIT_BAR(N) asm volatile("s_waitcnt vmcnt(" #N ") lgkmcnt(0)\n\ts_barrier" ::: "memory")
#define DA_SBAR() __builtin_amdgcn_sched_barrier(0)
__device__ __forceinline__ void qkt(f32x16& p0, f32x16& p1, const LAS unsigned char* kp, const bf16x8 (&qr)[4]) {
    p0 = (f32x16){}; p1 = (f32x16){};
#pragma unroll
    for (int d0 = 0; d0 < 4; ++d0) {
        const bf16x8 k0 = *(const LAS bf16x8*)(kp + d0 * 2048), k1 = *(const LAS bf16x8*)(kp + d0 * 2048 + 512);
        p0 = __builtin_amdgcn_mfma_f32_32x32x16_bf16(k0, qr[d0], p0, 0, 0, 0);
        p1 = __builtin_amdgcn_mfma_f32_32x32x16_bf16(k1, qr[d0], p1, 0, 0, 0); }
}
__device__ __forceinline__ float softmax_tile(f32x16& p0, f32x16& p1, float& m_reg, float& l_reg, bf16x8 (&pf)[4]) {
    float pmax = fmaxf(p0[0], p1[0]);
#pragma unroll
    for (int r = 1; r < 16; ++r) pmax = fmaxf(pmax, fmaxf(p0[r], p1[r]));
    { auto rr = __builtin_amdgcn_permlane32_swap(__float_as_uint(pmax), __float_as_uint(pmax), false, false); pmax = fmaxf(__uint_as_float(rr[0]), __uint_as_float(rr[1])); }
    float alpha = 1.f;
    if (!__builtin_expect(__all(pmax - m_reg <= THRL), 1)) { const float mn = fmaxf(m_reg, pmax); alpha = __builtin_amdgcn_exp2f(m_reg - mn); m_reg = mn; }
#pragma unroll
    for (int r = 0; r < 16; ++r) { p0[r] = __builtin_amdgcn_exp2f(p0[r] - m_reg); p1[r] = __builtin_amdgcn_exp2f(p1[r] - m_reg); }
    float ps = 0.f;
#pragma unroll
    for (int r = 0; r < 16; ++r) ps += p0[r] + p1[r];
    l_reg = l_reg * alpha + ps;
#pragma unroll
    for (int s = 0; s < 2; ++s) {
        v4u w0 = {cvtpk(p0[8 * s], p0[8 * s + 1]), cvtpk(p0[8 * s + 2], p0[8 * s + 3]), cvtpk(p0[8 * s + 4], p0[8 * s + 5]), cvtpk(p0[8 * s + 6], p0[8 * s + 7])};
        v4u w1 = {cvtpk(p1[8 * s], p1[8 * s + 1]), cvtpk(p1[8 * s + 2], p1[8 * s + 3]), cvtpk(p1[8 * s + 4], p1[8 * s + 5]), cvtpk(p1[8 * s + 6], p1[8 * s + 7])};
        pf[s] = __builtin_bit_cast(bf16x8, w0); pf[2 + s] = __builtin_bit_cast(bf16x8, w1); }
    return alpha;
}
__device__ __forceinline__ void pv(f32x16 (&o)[4], const LAS unsigned char* vp, const bf16x8 (&pf)[4]) {
#pragma unroll
    for (int d0 = 0; d0 < 4; ++d0) {
        s16x4 lo[4], hi[4];
#pragma unroll
        for (int s = 0; s < 4; ++s) { lo[s] = vtr(vp + s * 4096 + d0 * 512); hi[s] = vtr(vp + s * 4096 + 2048 + d0 * 512); }
        DA_SBAR();
#pragma unroll
        for (int s = 0; s < 4; ++s) {
            const bf16x8 a = (bf16x8){lo[s][0], lo[s][1], lo[s][2], lo[s][3], hi[s][0], hi[s][1], hi[s][2], hi[s][3]};
            o[d0] = __builtin_amdgcn_mfma_f32_32x32x16_bf16(a, pf[s], o[d0], 0, 0, 0); }
        DA_SBAR();
    }
}
__device__ __forceinline__ void da_unit(const Args& A, LAS unsigned char* lds, int unit, int tid, int lane, int wid) {
    const int b = unit >> 7, h = (unit >> 5) & 3, qb = unit & 31, r32 = lane & 31, hi = lane >> 5;
    const bf16* P = (const bf16*)(A.ws + WS_PROJ);
    const LAS unsigned char* kp0 = lds + LDS_K + hi * 1024 + r32 * 16;
    const LAS unsigned char* vp0 = lds + LDS_V + hi * 256 + ((lane >> 2) & 3) * 64 + ((lane >> 4) & 1) * 32 + (lane & 3) * 8;
    f32x16 o[4];
#pragma unroll 1
    for (int map = 0; map < 2; ++map) {
        const int hm = 2 * h + map;
        const unsigned char* kimg = A.ws + WS_DAK + (size_t)((b * 8 + hm) * 128) * 8192 + wid * 1024 + lane * 16;
        const unsigned char* vimg = A.ws + WS_DAV + (size_t)((b * 4 + h) * 128) * 16384 + wid * 2048 + lane * 16;
#define DA_DMA_K(t, slot) __builtin_amdgcn_global_load_lds((const unsigned*)(kimg + (size_t)(t) * 8192), (LAS unsigned*)(lds + LDS_K + (slot) * KSLOT + wid * 1024), 16, 0, 0)
#define DA_DMA_V(t, slot) do { __builtin_amdgcn_global_load_lds((const unsigned*)(vimg + (size_t)(t) * 16384), (LAS unsigned*)(lds + LDS_V + (slot) * VSLOT + wid * 2048), 16, 0, 0); \
                               __builtin_amdgcn_global_load_lds((const unsigned*)(vimg + (size_t)(t) * 16384 + 1024), (LAS unsigned*)(lds + LDS_V + (slot) * VSLOT + wid * 2048 + 1024), 16, 0, 0); } while (0)
        bf16x8 qr[4];
        { int r32o = r32, hio = hi; asm volatile("" : "+v"(r32o), "+v"(hio));
          const bf16* qrow = P + ((size_t)b * SEQ + qb * 256 + wid * 32 + r32o) * INC + O_DAQ + hm * 64 + hio * 8;
#pragma unroll
          for (int d0 = 0; d0 < 4; ++d0) qr[d0] = *(const GAS bf16x8*)(qrow + d0 * 16); }
        asm volatile("s_waitcnt vmcnt(0)" ::: "memory");
#pragma unroll
        for (int d0 = 0; d0 < 4; ++d0) o[d0] = (f32x16){};
        float m_reg = -1e30f, l_reg = 0.f;
        DA_DMA_K(0, 0); DA_DMA_V(0, 0); DA_DMA_K(1, 1); DA_DMA_V(1, 1);
        int s3 = 0;
#pragma unroll 1
        for (int j = 0; j < NT; ++j) {
            const int sp = (s3 == 0) ? 2 : s3 - 1; const int tn = (j + 2 < NT) ? j + 2 : NT - 1;
            DA_WAIT_BAR(3);
            DA_DMA_K(tn, sp); DA_DMA_V(tn, sp);
            f32x16 p0, p1; bf16x8 pf[4];
            qkt(p0, p1, kp0 + s3 * KSLOT, qr);
            const float al = softmax_tile(p0, p1, m_reg, l_reg, pf);
            if (__any(al < 1.f)) {
#pragma unroll
                for (int d_ = 0; d_ < 4; ++d_) o[d_] = o[d_] * al; }
            pv(o, vp0 + s3 * VSLOT, pf);
            s3 = (s3 == 2) ? 0 : s3 + 1;
        }
        DA_WAIT_BAR(0);
        { auto rr = __builtin_amdgcn_permlane32_swap(__float_as_uint(l_reg), __float_as_uint(l_reg), false, false); l_reg = __uint_as_float(rr[0]) + __uint_as_float(rr[1]); }
        const float il = 1.f / l_reg;
        int tide = tid; asm volatile("" : "+v"(tide));
        const int lanee = tide & 63, hie = (tide >> 5) & 1;
        GAS f32x4* stash = (GAS f32x4*)(A.out) + (size_t)unit * 16 * NTHR + tide;
        if (map == 0) {
#pragma unroll
            for (int d0 = 0; d0 < 4; ++d0)
#pragma unroll
                for (int g = 0; g < 4; ++g) stash[(size_t)(d0 * 4 + g) * NTHR] = (f32x4){o[d0][4 * g] * il, o[d0][4 * g + 1] * il, o[d0][4 * g + 2] * il, o[d0][4 * g + 3] * il};
        } else {
            const float lam = __expf(wave_sum(A.lq1[lanee] * A.lk1[lanee])) - __expf(wave_sum(A.lq2[lanee] * A.lk2[lanee])) + LAMBDA_INIT;
            const float c2 = lam * il; float ss = 0.f;
#pragma unroll
            for (int d0 = 0; d0 < 4; ++d0)
#pragma unroll
                for (int g = 0; g < 4; ++g) { const f32x4 o1 = stash[(size_t)(d0 * 4 + g) * NTHR];
#pragma unroll
                    for (int e = 0; e < 4; ++e) { const float v = o1[e] - c2 * o[d0][4 * g + e]; o[d0][4 * g + e] = v; ss += v * v; } }
            { auto rr = __builtin_amdgcn_permlane32_swap(__float_as_uint(ss), __float_as_uint(ss), false, false); ss = __uint_as_float(rr[0]) + __uint_as_float(rr[1]); }
            const float rs = (1.f - LAMBDA_INIT) / sqrtf(ss * (1.f / 128.f) + LN_EPS);
            bf16* crow_p = (bf16*)(A.ws + WS_CAT) + ((size_t)b * SEQ + qb * 256 + wid * 32 + (lanee & 31)) * DM + 512 + h * 128 + 4 * hie;
#pragma unroll
            for (int d0 = 0; d0 < 4; ++d0)
#pragma unroll
                for (int g = 0; g < 4; ++g) { const int d = 32 * d0 + 8 * g; const f32x4 gg = *(const f32x4*)(A.subln_g + d + 4 * hie);
                    *(GAS v2u*)(crow_p + d) = (v2u){pk2(o[d0][4 * g] * rs * gg.x, o[d0][4 * g + 1] * rs * gg.y), pk2(o[d0][4 * g + 2] * rs * gg.z, o[d0][4 * g + 3] * rs * gg.w)}; }
        }
#undef DA_DMA_K
#undef DA_DMA_V
    }
}
}

__global__ void __launch_bounds__(NTHR, 2) fwd_kernel(Args A) {
    extern __shared__ __attribute__((aligned(16))) unsigned char lds_raw[];
    LAS unsigned char* lds = (LAS unsigned char*)lds_raw;
    const int tid = threadIdx.x, lane = tid & 63, wave = __builtin_amdgcn_readfirstlane(tid >> 6);
    const int G = gridDim.x; const int bx = blockIdx.x; const int vcu = (G % 8 == 0) ? (bx % 8) * (G / 8) + bx / 8 : bx;
    const int gw = vcu * NWAVES + wave, NGW = G * NWAVES;
    volatile LAS unsigned* MISC = (volatile LAS unsigned*)(lds + MISC_OFF);
    for (int u = tid; u < (LDS_BYTES - LDSCTL_OFF) / 4; u += NTHR) ((LAS unsigned*)(lds + LDSCTL_OFF))[u] = 0u;
    __syncthreads();
    unsigned* barw = (unsigned*)(A.ws + WS_CTL) + CW_BAR;
    XcdBarrier bar; bar.bar = barw; bar.x = 0; bar.st = nullptr;
    const int lo = A.ph_lo, hi = A.ph_hi;
    if (hi - lo > 1) bar = xcd_barrier_post(barw, MISC + 8);
#define IN(k) (lo <= (k) && (k) < hi)
#define SEAM(k) do { if (IN(k) && IN((k) + 1)) xcd_barrier(bar); } while (0)
    unsigned char* ws = A.ws;
    const float* mod = (const float*)(ws + WS_MOD);

    if (IN(0)) { p0_prologue(A, lds, tid, lane, wave, vcu, G); }
    SEAM(0);
    if (IN(1)) { p1_ln_mod(A, lane, gw, NGW); }
    SEAM(1);
    if (IN(2)) {
        pg8::Gemm g{(const bf16*)(ws + WS_XN), (const bf16*)(ws + WS_WIN), M, INC, DM}; pg8::StaticOrder S; S.init(M, INC, G, bx);
        pg8::EpiFn<FProj> E{FProj{ws}};
        pg8::gemm_phase<pg8::EpiFn<FProj>, pg8::StaticOrder, true, true>(lds, g, S, E);
    }
    SEAM(2);
    if (IN(3)) { na::na_phase(A, lane, wave, vcu, G); __syncthreads(); for (int u = vcu; u < 256; u += G) da::da_unit(A, lds, u, tid, lane, wave); }
    SEAM(3);
    if (IN(4)) {
        pg8::Gemm g{(const bf16*)(ws + WS_CAT), (const bf16*)(ws + WS_WOUT), M, DM, DM}; pg8::StaticOrder S; S.init(M, DM, G, bx);
        pg8::EpiFn<FRes> E{FRes{A.x, A.out, mod + 2048}};
        pg8::gemm_phase<pg8::EpiFn<FRes>, pg8::StaticOrder, true, true>(lds, g, S, E);
    }
    SEAM(4);
    if (IN(5)) { ln_affine_pass<true>(A, A.ln1_g, A.ln1_b, lane, gw, NGW); }
    SEAM(5);
    if (IN(6)) {
        pg8::Gemm g{(const bf16*)(ws + WS_XN), (const bf16*)(ws + WS_WGU), M, NGU, DM}; pg8::StaticOrder S; S.init(M, NGU, G, bx);
        pg8::EpiFn<FGU> E{FGU{(bf16*)(ws + WS_H)}};
        pg8::gemm_phase<pg8::EpiFn<FGU>, pg8::StaticOrder, true, true>(lds, g, S, E);
    }
    SEAM(6);
    if (IN(7)) {
        pg8::Gemm g{(const bf16*)(ws + WS_H), (const bf16*)(ws + WS_WD), M, DM, DFF}; pg8::StaticOrder S; S.init(M, DM, G, bx);
        pg8::EpiFn<FRes> E{FRes{A.out, A.out, mod + 5120}};
        pg8::gemm_phase<pg8::EpiFn<FRes>, pg8::StaticOrder, true, true>(lds, g, S, E);
    }
    SEAM(7);
    if (IN(8)) { ln_affine_pass<false>(A, A.ln2_g, A.ln2_b, lane, gw, NGW); }
#undef IN
#undef SEAM
}

extern "C" void kernel_launch(void* const* d_in, const int* in_sizes, int n_in, void* d_out, int out_size, void* d_ws, size_t ws_size, hipStream_t stream) {
    static int grid = 0;
    if (grid == 0) {
        if (n_in != 19 || in_sizes[0] != M * DM || out_size != M * DM || ws_size < WS_END) { fprintf(stderr, "kernel_launch: unexpected shapes (n_in %d, in0 %d, out %d, ws %zu)\n", n_in, n_in > 0 ? in_sizes[0] : -1, out_size, ws_size); grid = -1; return; }
        int dev = 0, cus = 0, per_cu = 0;
        if (hipGetDevice(&dev) != hipSuccess || hipDeviceGetAttribute(&cus, hipDeviceAttributeMultiprocessorCount, dev) != hipSuccess) { grid = -1; return; }
        if (hipFuncSetAttribute((const void*)fwd_kernel, hipFuncAttributeMaxDynamicSharedMemorySize, LDS_BYTES) != hipSuccess) { fprintf(stderr, "kernel_launch: hipFuncSetAttribute failed\n"); grid = -1; return; }
        if (hipOccupancyMaxActiveBlocksPerMultiprocessor(&per_cu, (const void*)fwd_kernel, NTHR, LDS_BYTES) != hipSuccess || per_cu < 1) { fprintf(stderr, "kernel_launch: occupancy query says %d blocks/CU\n", per_cu); (void)hipGetLastError(); grid = -1; return; }
        grid = cus;
    }
    if (grid < 0) return;
    Args a{};
    a.x = (const float*)d_in[0]; a.c = (const float*)d_in[1]; a.w_ada = (const float*)d_in[2]; a.b_ada = (const float*)d_in[3]; a.w_in = (const float*)d_in[4]; a.rpb = (const float*)d_in[5];
    a.lq1 = (const float*)d_in[6]; a.lk1 = (const float*)d_in[7]; a.lq2 = (const float*)d_in[8]; a.lk2 = (const float*)d_in[9]; a.subln_g = (const float*)d_in[10]; a.w_out = (const float*)d_in[11];
    a.ln1_g = (const float*)d_in[12]; a.ln1_b = (const float*)d_in[13]; a.w_gate = (const float*)d_in[14]; a.w_up = (const float*)d_in[15]; a.w_down = (const float*)d_in[16]; a.ln2_g = (const float*)d_in[17]; a.ln2_b = (const float*)d_in[18];
    a.out = (float*)d_out; a.ws = (unsigned char*)d_ws;
    for (int i = 0; i < 32; ++i) a.freq[i] = 1.0f / powf(10000.0f, (float)i / 32.0f);
    if (MK_N_LAUNCHES == 1) {
        if (hipMemsetAsync((char*)d_ws + WS_CTL, 0, CTL_ZERO_BYTES, stream) != hipSuccess) return;
        a.ph_lo = 0; a.ph_hi = N_PHASES;
        hipLaunchKernelGGL(fwd_kernel, dim3(grid), dim3(NTHR), LDS_BYTES, stream, a);
    } else {
        for (int p = 0; p < N_PHASES; ++p) { a.ph_lo = p; a.ph_hi = p + 1; hipLaunchKernelGGL(fwd_kernel, dim3(grid), dim3(NTHR), LDS_BYTES, stream, a); }
    }
    const hipError_t le = hipPeekAtLastError();
    if (le != hipSuccess) fprintf(stderr, "kernel_launch: launch failed: %s\n", hipGetErrorName(le));
}
```

```cpp
#include <hip/hip_runtime.h>
#include <cstdio>
#include <cstdint>
#include <cmath>

#ifndef MK_N_LAUNCHES
#define MK_N_LAUNCHES 1
#endif

constexpr int BATCH = 2, SEQ = 8192, DM = 1024, M = BATCH * SEQ;
constexpr int GRID_W = 64, NA_HEADS = 8, HD = 64, NA_KR = 8, NA_KC = 16, ROWS = SEQ / GRID_W;
constexpr int DA_HEADS = 4, DA_V = 128;
constexpr int INC = 3072, DFF = 2816, NGU = 2 * DFF;
constexpr int O_NAQ = 0, O_NAK = 512, O_NAV = 1024, O_DAQ = 1536, O_DAK = 2048, O_DAV = 2560;
constexpr float LN_EPS = 1e-5f;
constexpr float ALPHA = 1.189207115002721f;
constexpr float LAMBDA_INIT = 0.2f;
constexpr float C2 = 0.125f * 1.4426950408889634f;

namespace pg8 {
#define PG8_LAS __attribute__((address_space(3)))
typedef unsigned short bf16_t;
typedef short bf16x8 __attribute__((ext_vector_type(8)));
typedef float f32x4 __attribute__((ext_vector_type(4)));
typedef unsigned u32x4 __attribute__((ext_vector_type(4)));
constexpr int BM = 256, BK = 64, HALF = 128, HTB = HALF * BK * 2, STAGE_BYTES = 8 * HTB, NXCD = 8, WGM = 8;

__host__ __device__ __forceinline__ int lds_byte(int r, int c) { const int st = (r >> 4) * 2 + (c >> 5), rr = r & 15, cc = c & 31, ob = rr * 64 + cc * 2; return st * 1024 + (ob ^ (((ob >> 9) & 1) << 5)); }
__host__ __device__ __forceinline__ void stage_rc(int b, int& R, int& C) { const int st = b / 1024, sb = b % 1024, swz = sb ^ (((sb >> 9) & 1) << 5); R = (st >> 1) * 16 + swz / 64; C = (st & 1) * 32 + (swz % 64) / 2; }
__host__ __device__ __forceinline__ int perm32(int rho) { const int n = rho >> 4, i = rho & 15; return 8 * (i >> 2) + 4 * n + (i & 3); }

struct Unit { int pm, pn; };
struct Gemm { const bf16_t* A; const bf16_t* Bt; int M, N, K; };

struct StaticOrder {
    int nM, nN, nwg, G, c;
    __host__ __device__ void init(int M_, int N_, int G_, int c_) { nM = M_ / BM; nN = N_ / BM; nwg = nM * nN; G = G_; c = c_; }
    __host__ __device__ bool next(int i, Unit& u) const {
        const long L = (long)i * G + c; if (L >= nwg) return false;
        int wgid = (int)L; { const int q = nwg / NXCD, r = nwg % NXCD, xcd = wgid % NXCD, off = wgid / NXCD; wgid = (xcd < r ? xcd * (q + 1) : r * (q + 1) + (xcd - r) * q) + off; }
        const int nig = WGM * nN, gid = wgid / nig, fm = gid * WGM, gsz = (nM - fm) < WGM ? (nM - fm) : WGM;
        u.pm = fm + ((wgid % nig) % gsz); u.pn = (wgid % nig) / gsz; return true;
    }
    __device__ __forceinline__ void a_ready(const Unit&) const {}
    __device__ __forceinline__ void done(const Unit&) const {}
};

template <class F> struct EpiFn {
    static constexpr bool PERM = false, AFTER_DRAIN = false; F f;
    __device__ __forceinline__ void operator()(const f32x4 (&acc)[2][2][4][2], const Unit& u, int wr, int wc, int fr, int fq) const {
        asm volatile("" : "+v"(fr), "+v"(fq));
#pragma unroll
        for (int ai = 0; ai < 2; ++ai)
#pragma unroll
            for (int m = 0; m < 4; ++m) { const int row = u.pm * BM + ai * HALF + wr * 64 + m * 16 + fr;
#pragma unroll
                for (int bj = 0; bj < 2; ++bj)
#pragma unroll
                    for (int n = 0; n < 2; ++n) f(row, u.pn * BM + bj * HALF + wc * 32 + n * 16 + 4 * fq, acc[ai][bj][m][n], u.pn); }
    }
    __device__ __forceinline__ void fused(f32x4 (&)[2][2][4][2], const Unit&, int, int, int, int, PG8_LAS unsigned char*, int, int) const {}
};

template <class Epi, class Sched, bool ALIGN_EPI = false, bool SP2 = false>
__device__ __forceinline__ void gemm_phase(PG8_LAS unsigned char* lds, const Gemm g, const Sched& S, const Epi& E) {
    const int tid = threadIdx.x, wid = __builtin_amdgcn_readfirstlane(tid >> 6), lane = tid & 63, wr = wid >> 2, wc = wid & 3, fr = lane & 15, fq = lane >> 4;
    const int K = g.K, nt = K / BK;
    unsigned voffA[2], voffB[2];
#pragma unroll
    for (int i = 0; i < 2; ++i) { int R, C; stage_rc(tid * 16 + i * 8192, R, C); const int Rb = Epi::PERM ? ((R & ~31) + perm32(R & 31)) : R;
        voffA[i] = (unsigned)(R * K + C) * 2u; voffB[i] = (unsigned)(Rb * K + C) * 2u; }
    const size_t kstep = (size_t)(BK * 2);
    const size_t hstep = (size_t)HALF * K * 2;
    const size_t tstep = 2 * hstep;
    const unsigned ldsw = (unsigned)wid * 1024u;
    const int aoff = lds_byte(wr * 64 + fr, fq * 8), boff = lds_byte(wc * 32 + fr, fq * 8);
#define PG8_SA(b, h) (((b) * 2 + (h)) * HTB)
#define PG8_SB(b, h) ((4 + (b) * 2 + (h)) * HTB)
#define PG8_STAGE(bufoff, gbase, voff) do { _Pragma("unroll") for (int _i = 0; _i < 2; ++_i) \
        __builtin_amdgcn_global_load_lds((const unsigned*)((const char*)(gbase) + (voff)[_i]), (PG8_LAS unsigned*)(lds + (bufoff) + ldsw + _i * 8192), 16, 0, 0); } while (0)
#define PG8_LDA(dst, b, h) do { _Pragma("unroll") for (int m = 0; m < 4; ++m) _Pragma("unroll") for (int k = 0; k < 2; ++k) dst[m][k] = *(const PG8_LAS bf16x8*)(lds + PG8_SA(b, h) + aoff + m * 2048 + k * 1024); } while (0)
#define PG8_LDB(dst, b, h) do { _Pragma("unroll") for (int n = 0; n < 2; ++n) _Pragma("unroll") for (int k = 0; k < 2; ++k) dst[n][k] = *(const PG8_LAS bf16x8*)(lds + PG8_SB(b, h) + boff + n * 2048 + k * 1024); } while (0)
#define PG8_MMA(ai, bj, At, Bt) do { __builtin_amdgcn_s_setprio(1); _Pragma("unroll") for (int m = 0; m < 4; ++m) _Pragma("unroll") for (int n = 0; n < 2; ++n) _Pragma("unroll") for (int k = 0; k < 2; ++k) \
        acc[ai][bj][m][n] = __builtin_amdgcn_mfma_f32_16x16x32_bf16(Bt[n][k], At[m][k], acc[ai][bj][m][n], 0, 0, 0); __builtin_amdgcn_s_setprio(0); } while (0)
#define PG8_WAIT_V(n) asm volatile("s_waitcnt vmcnt(" #n ")" ::: "memory")
#define PG8_WAIT_L(n) asm volatile("s_waitcnt lgkmcnt(" #n ")" ::: "memory")
#define PG8_BAR __builtin_amdgcn_s_barrier()
#define PG8_SCHED __builtin_amdgcn_sched_barrier(0)
    Unit cur, nxt; int ui = 0;
    if (!S.next(0, cur)) return;
    f32x4 acc[2][2][4][2];
#pragma unroll
    for (int a = 0; a < 2; ++a)
#pragma unroll
        for (int b = 0; b < 2; ++b)
#pragma unroll
            for (int m = 0; m < 4; ++m)
#pragma unroll
                for (int n = 0; n < 2; ++n) acc[a][b][m][n] = (f32x4){0.f, 0.f, 0.f, 0.f};
    bf16x8 At[4][2], B0[2][2], B1[2][2];
    const char* cA = (const char*)g.A + (size_t)cur.pm * tstep; const char* cB = (const char*)g.Bt + (size_t)cur.pn * tstep;
    S.a_ready(cur);
    if constexpr (SP2) {
        PG8_STAGE(PG8_SB(0, 0), cB, voffB); PG8_STAGE(PG8_SB(0, 1), cB + hstep, voffB); PG8_STAGE(PG8_SA(0, 0), cA, voffA); PG8_STAGE(PG8_SA(0, 1), cA + hstep, voffA);
        if (wr == 1) PG8_BAR;
        PG8_WAIT_V(2); PG8_BAR;
        PG8_STAGE(PG8_SB(1, 0), cB + kstep, voffB); PG8_STAGE(PG8_SA(1, 0), cA + kstep, voffA); PG8_STAGE(PG8_SB(1, 1), cB + hstep + kstep, voffB);
        PG8_WAIT_V(6); PG8_BAR;
    } else {
        PG8_STAGE(PG8_SB(0, 0), cB, voffB); PG8_STAGE(PG8_SA(0, 0), cA, voffA); PG8_STAGE(PG8_SB(0, 1), cB + hstep, voffB); PG8_STAGE(PG8_SA(0, 1), cA + hstep, voffA);
        if (wr == 1) PG8_BAR;
        PG8_WAIT_V(4); PG8_BAR;
        PG8_STAGE(PG8_SB(1, 0), cB + kstep, voffB); PG8_STAGE(PG8_SA(1, 0), cA + kstep, voffA); PG8_STAGE(PG8_SB(1, 1), cB + hstep + kstep, voffB);
        PG8_WAIT_V(6); PG8_BAR;
    }
    for (;;) {
        const bool has_next = S.next(ui + 1, nxt);
        const char* nA = has_next ? (const char*)g.A + (size_t)nxt.pm * tstep : cA; const char* nB = has_next ? (const char*)g.Bt + (size_t)nxt.pn * tstep : cB;
        for (int t = 0; t < nt; t += 2) {
            const bool last = (t == nt - 2);
            const char* a1 = cA + (size_t)(t + 1) * kstep;
            const char* a2 = last ? nA : cA + (size_t)(t + 2) * kstep; const char* b2 = last ? nB : cB + (size_t)(t + 2) * kstep;
            const char* a3 = a2 + kstep; const char* b3 = b2 + kstep;
            if (last && has_next) S.a_ready(nxt);
            if constexpr (SP2) {
            PG8_LDB(B0, 0, 0); PG8_LDB(B1, 0, 1); PG8_SCHED; PG8_LDA(At, 0, 0); PG8_STAGE(PG8_SA(1, 1), a1 + hstep, voffA);
            PG8_WAIT_V(8); PG8_WAIT_L(0); PG8_BAR; PG8_MMA(0, 0, At, B0); PG8_MMA(0, 1, At, B1); PG8_BAR; PG8_SCHED;
            PG8_LDA(At, 0, 1); PG8_STAGE(PG8_SB(0, 0), b2, voffB); PG8_STAGE(PG8_SB(0, 1), b2 + hstep, voffB); PG8_STAGE(PG8_SA(0, 0), a2, voffA);
            PG8_WAIT_V(8); PG8_WAIT_L(0); PG8_BAR; PG8_MMA(1, 0, At, B0); PG8_MMA(1, 1, At, B1); PG8_BAR; PG8_SCHED;
            PG8_LDB(B0, 1, 0); PG8_LDB(B1, 1, 1); PG8_SCHED; PG8_LDA(At, 1, 0); PG8_STAGE(PG8_SA(0, 1), a2 + hstep, voffA);
            PG8_WAIT_V(8); PG8_WAIT_L(0); PG8_BAR; PG8_MMA(0, 0, At, B0); PG8_MMA(0, 1, At, B1); PG8_BAR; PG8_SCHED;
            PG8_LDA(At, 1, 1); PG8_STAGE(PG8_SB(1, 0), b3, voffB); PG8_STAGE(PG8_SB(1, 1), b3 + hstep, voffB); PG8_STAGE(PG8_SA(1, 0), a3, voffA);
            PG8_WAIT_V(8); PG8_WAIT_L(0); PG8_BAR; PG8_MMA(1, 0, At, B0); PG8_MMA(1, 1, At, B1); PG8_BAR; PG8_SCHED;
            } else {
            PG8_LDB(B0, 0, 0); PG8_SCHED; PG8_LDA(At, 0, 0); PG8_STAGE(PG8_SA(1, 1), a1 + hstep, voffA);
            PG8_WAIT_L(8); PG8_BAR; PG8_WAIT_L(0); PG8_MMA(0, 0, At, B0); PG8_BAR; PG8_SCHED;
            PG8_LDB(B1, 0, 1); PG8_STAGE(PG8_SB(0, 0), b2, voffB);
            PG8_BAR; PG8_WAIT_L(0); PG8_MMA(0, 1, At, B1); PG8_BAR;
            PG8_LDA(At, 0, 1); PG8_STAGE(PG8_SA(0, 0), a2, voffA);
            PG8_BAR; PG8_WAIT_L(0); PG8_MMA(1, 0, At, B0); PG8_BAR; PG8_SCHED;
            PG8_STAGE(PG8_SB(0, 1), b2 + hstep, voffB);
            PG8_WAIT_V(6); PG8_BAR; PG8_MMA(1, 1, At, B1); PG8_BAR;
            PG8_LDB(B0, 1, 0); PG8_SCHED; PG8_LDA(At, 1, 0); PG8_STAGE(PG8_SA(0, 1), a2 + hstep, voffA);
            PG8_WAIT_L(8); PG8_BAR; PG8_WAIT_L(0); PG8_MMA(0, 0, At, B0); PG8_BAR; PG8_SCHED;
            PG8_LDB(B1, 1, 1); PG8_STAGE(PG8_SB(1, 0), b3, voffB);
            PG8_BAR; PG8_WAIT_L(0); PG8_MMA(0, 1, At, B1); PG8_BAR;
            PG8_LDA(At, 1, 1); PG8_STAGE(PG8_SA(1, 0), a3, voffA);
            PG8_BAR; PG8_WAIT_L(0); PG8_MMA(1, 0, At, B0); PG8_BAR; PG8_SCHED;
            PG8_STAGE(PG8_SB(1, 1), b3 + hstep, voffB);
            PG8_WAIT_V(6); PG8_BAR; PG8_MMA(1, 1, At, B1); PG8_BAR;
            }
        }
        if constexpr (ALIGN_EPI) { if (wr == 0) PG8_BAR; }
        if constexpr (!Epi::AFTER_DRAIN) { E(acc, cur, wr, wc, fr, fq); S.done(cur); }
        if (!has_next) break;
#pragma unroll
        for (int a = 0; a < 2; ++a)
#pragma unroll
            for (int b = 0; b < 2; ++b)
#pragma unroll
                for (int m = 0; m < 4; ++m)
#pragma unroll
                    for (int n = 0; n < 2; ++n) acc[a][b][m][n] = (f32x4){0.f, 0.f, 0.f, 0.f};
        cur = nxt; cA = nA; cB = nB; ++ui;
        if constexpr (ALIGN_EPI) { if (wr == 1) PG8_BAR; }
    }
    PG8_WAIT_V(0);
    if constexpr (!ALIGN_EPI) { if (wr == 0) PG8_BAR; }
    PG8_BAR;
    if constexpr (Epi::AFTER_DRAIN) { E.fused(acc, cur, wr, wc, fr, fq, lds, wid, lane); S.done(cur); }
#undef PG8_SA
#undef PG8_SB
#undef PG8_STAGE
#undef PG8_LDA
#undef PG8_LDB
#undef PG8_MMA
#undef PG8_WAIT_V
#undef PG8_WAIT_L
#undef PG8_BAR
#undef PG8_SCHED
}
}

constexpr int NWAVES = 8, NTHR = NWAVES * 64;
constexpr int N_PHASES = 9;
constexpr size_t MiB = 1u << 20;
constexpr size_t WS_CTL = 0, CTL_ZERO_BYTES = 64 * 1024;
constexpr size_t WS_MOD = 1 * MiB;
constexpr size_t WS_ROPE = 2 * MiB;
constexpr size_t WS_WIN = 4 * MiB;
constexpr size_t WS_WOUT = 10 * MiB;
constexpr size_t WS_WGU = 12 * MiB;
constexpr size_t WS_WD = 23 * MiB;
constexpr size_t WS_XN = 32 * MiB;
constexpr size_t WS_PROJ = 64 * MiB;
constexpr size_t WS_H = WS_PROJ;
constexpr size_t WS_CAT = 160 * MiB;
constexpr size_t WS_DAK = 192 * MiB;
constexpr size_t WS_DAV = 208 * MiB;
constexpr size_t WS_NAVT = 224 * MiB;
constexpr size_t WS_END = 256 * MiB;
constexpr int CW_BAR = 1024;
constexpr int RING_BYTES = 131072, LDSCTL_OFF = RING_BYTES, MISC_OFF = LDSCTL_OFF + 320, LDS_BYTES = 147456;

#define GAS __attribute__((address_space(1)))
#define LAS __attribute__((address_space(3)))
typedef unsigned short bf16;
typedef unsigned v4u __attribute__((ext_vector_type(4)));
typedef unsigned v2u __attribute__((ext_vector_type(2)));
typedef float f32x4 __attribute__((ext_vector_type(4)));
typedef float f32x2 __attribute__((ext_vector_type(2)));
#define LDS_WAIT() asm volatile("s_waitcnt lgkmcnt(0)" ::: "memory")
#define VM_WAIT() asm volatile("s_waitcnt vmcnt(0)" ::: "memory")
__device__ __forceinline__ unsigned f2bf(float f) { unsigned u = __builtin_bit_cast(unsigned, f); return (u + 0x7fffu + ((u >> 16) & 1u)) >> 16; }
__device__ __forceinline__ unsigned pk2(float lo, float hi) { return f2bf(lo) | (f2bf(hi) << 16); }
__device__ __forceinline__ float bflo(unsigned w) { return __builtin_bit_cast(float, w << 16); }
__device__ __forceinline__ float bfhi(unsigned w) { return __builtin_bit_cast(float, w & 0xffff0000u); }
__device__ __forceinline__ float wave_sum(float v) {
#pragma unroll
    for (int o = 1; o < 64; o <<= 1) v += __shfl_xor(v, o);
    return v;
}

#define XB_TMO      128
#define XB_XCNT(j)  (256  + 64 * (j))
#define XB_XSUB(j)  (1280 + 64 * (j))
#define XB_XGEN(j)  (2304 + 64 * (j))
#define XB_TOP      3328
#define XB_TOPGEN   3392
#define XCD_BAR_WORDS 3456
#define XB_SPIN_CAP (1u << 18)
__device__ __forceinline__ unsigned xb_ld(unsigned* p)              { return __hip_atomic_load(p, __ATOMIC_RELAXED, __HIP_MEMORY_SCOPE_AGENT); }
__device__ __forceinline__ unsigned xb_add(unsigned* p, unsigned v) { return __hip_atomic_fetch_add(p, v, __ATOMIC_RELAXED, __HIP_MEMORY_SCOPE_AGENT); }
__device__ __forceinline__ unsigned xb_xcc_id() { return (unsigned)__builtin_amdgcn_s_getreg((3 << 11) | 20) & 0xFu; }
#define XB_SPIN(cond, bar) do { unsigned _sp = 0; while (cond) { __builtin_amdgcn_s_sleep(1); \
    if ((++_sp & 255u) == 0u) { if (xb_ld(&(bar)[XB_TMO])) break; if (_sp > XB_SPIN_CAP) { atomicAdd(&(bar)[XB_TMO], 1u); break; } } } } while (0)
struct XcdBarrier { unsigned* bar; unsigned x; volatile LAS unsigned* st; };
__device__ __forceinline__ XcdBarrier xcd_barrier_post(unsigned* bar, volatile LAS unsigned* st) {
    XcdBarrier b; b.bar = bar; b.x = xb_xcc_id(); b.st = st;
    if (threadIdx.x == 0) (void)xb_add(&bar[XB_XCNT(b.x)], 1u);
    return b;
}
__device__ __forceinline__ void xcd_barrier_complete(unsigned* bar, unsigned x, unsigned& nloc, unsigned& nx) {
    const unsigned G = gridDim.x * gridDim.y * gridDim.z;
    unsigned sum, cnt, mine, sp = 0u;
    for (;;) {
        sum = 0u; cnt = 0u; mine = 0u;
#pragma unroll
        for (unsigned j = 0; j < 16; ++j) { const unsigned c = xb_ld(&bar[XB_XCNT(j)]); sum += c; cnt += (c > 0u) ? 1u : 0u; mine = (j == x) ? c : mine; }
        if (sum == G) break;
        __builtin_amdgcn_s_sleep(1);
        if ((++sp & 255u) == 0u) { if (xb_ld(&bar[XB_TMO])) break; if (sp > XB_SPIN_CAP) { atomicAdd(&bar[XB_TMO], 1u); break; } }
    }
    nloc = mine > 0u ? mine : 1u; nx = cnt > 0u ? cnt : 1u;
}
__device__ __forceinline__ void xcd_barrier(const XcdBarrier& b) {
    asm volatile("s_waitcnt vmcnt(0)" ::: "memory");
    __syncthreads();
    if (threadIdx.x == 0) {
        unsigned* bar = b.bar;
        __builtin_amdgcn_s_waitcnt(0);
        unsigned nloc = b.st[0], nx = b.st[1];
        if (nloc == 0u) { xcd_barrier_complete(bar, b.x, nloc, nx); b.st[0] = nloc; b.st[1] = nx; }
        const unsigned old = xb_add(&bar[XB_XSUB(b.x)], 1u);
        const unsigned gen = old / nloc;
        if (old + 1u == (gen + 1u) * nloc) {
            __builtin_amdgcn_fence(__ATOMIC_RELEASE, "agent");
            asm volatile("s_waitcnt vmcnt(0)" ::: "memory");
            const unsigned og = xb_add(&bar[XB_TOP], 1u);
            const unsigned tg = og / nx;
            if (og + 1u == (tg + 1u) * nx) xb_add(&bar[XB_TOPGEN], 1u);
            else XB_SPIN(xb_ld(&bar[XB_TOPGEN]) == tg, bar);
            __builtin_amdgcn_fence(__ATOMIC_ACQUIRE, "agent");
            xb_add(&bar[XB_XGEN(b.x)], 1u);
            asm volatile("s_waitcnt vmcnt(0)" ::: "memory");
        } else {
            XB_SPIN(xb_ld(&bar[XB_XGEN(b.x)]) == gen, bar);
            __builtin_amdgcn_fence(__ATOMIC_ACQUIRE, "agent");
            asm volatile("s_waitcnt vmcnt(0)" ::: "memory");
        }
    }
    __syncthreads();
}

struct Args {
    const float* x; const float* c; const float* w_ada; const float* b_ada; const float* w_in; const float* rpb;
    const float* lq1; const float* lk1; const float* lq2; const float* lk2; const float* subln_g; const float* w_out;
    const float* ln1_g; const float* ln1_b; const float* w_gate; const float* w_up; const float* w_down; const float* ln2_g; const float* ln2_b;
    float* out; unsigned char* ws; int ph_lo, ph_hi; float freq[32];
};

__device__ __forceinline__ int dst_row(int mat, int n) {
    if (mat == 0) { if (n < O_DAQ || n >= O_DAV) return n; const int d = n & 63; return (n & ~63) + (d < 32 ? 2 * d : 2 * (d - 32) + 1); }
    if (mat == 2) return 2 * n;
    if (mat == 3) return 2 * n + 1;
    return n;
}
__device__ __forceinline__ void p0_transpose_item(const float* W, int K, int N, bf16* WT, int mat, LAS float* scr, int item, int lane) {
    const int nblk = N / 32, kb = item / nblk, nb = item % nblk, k0 = 64 * kb, n0 = 32 * nb;
#pragma unroll 8
    for (int i = 0; i < 32; ++i) { const int kk = 2 * i + (lane >> 5); scr[kk * 33 + (lane & 31)] = W[(size_t)(k0 + kk) * N + n0 + (lane & 31)]; }
    LDS_WAIT(); asm volatile("" ::: "memory");
    const int c = lane & 7;
#pragma unroll
    for (int j = 0; j < 4; ++j) { const int n = (lane >> 3) + 8 * j; const LAS float* s = scr + (8 * c) * 33 + n;
        v4u o; o.x = pk2(s[0 * 33], s[1 * 33]); o.y = pk2(s[2 * 33], s[3 * 33]); o.z = pk2(s[4 * 33], s[5 * 33]); o.w = pk2(s[6 * 33], s[7 * 33]);
        *(GAS v4u*)(WT + (size_t)dst_row(mat, n0 + n) * K + k0 + 8 * c) = o; }
    LDS_WAIT(); asm volatile("" ::: "memory");
}
__device__ __forceinline__ void sincos_d(double a, float& co, float& si) {
    const double k = __builtin_rint(a * 0.63661977236758134308);
    const double r = __builtin_fma(-k, 1.57079632679489661923, a) - k * 6.123233995736766e-17;
    const double r2 = r * r;
    double s = -2.5052108385441718775e-8; s = s * r2 + 2.7557319223985890653e-6; s = s * r2 - 1.9841269841269841270e-4; s = s * r2 + 8.3333333333333333333e-3; s = s * r2 - 1.6666666666666666667e-1; s = s * r2 * r + r;
    double c = 2.0876756987868098979e-9; c = c * r2 - 2.7557319223985890653e-7; c = c * r2 + 2.4801587301587301587e-5; c = c * r2 - 1.3888888888888888889e-3; c = c * r2 + 4.1666666666666666667e-2; c = c * r2 - 0.5; c = c * r2 + 1.0;
    const int q = (int)((long long)k & 3);
    const double cc = (q == 0) ? c : (q == 1) ? -s : (q == 2) ? -c : s;
    const double ss = (q == 0) ? s : (q == 1) ? c : (q == 2) ? -s : -c;
    co = (float)cc; si = (float)ss;
}
__device__ __forceinline__ void p0_prologue(const Args& A, LAS unsigned char* lds, int tid, int lane, int wave, int vcu, int G) {
    unsigned char* ws = A.ws;
    { LAS float* part = (LAS float*)lds;
      float* mod = (float*)(ws + WS_MOD);
      for (int it = vcu; it < 6144 / 32; it += G) {
          const int col = tid & 31, ks = tid >> 5, j = it * 32 + col; float a0 = 0.f, a1 = 0.f;
#pragma unroll 8
          for (int k = ks * 64; k < ks * 64 + 64; ++k) { const float w = A.w_ada[(size_t)k * 6144 + j]; const float c0 = A.c[k], c1 = A.c[1024 + k];
              a0 += (c0 / (1.f + __expf(-c0))) * w; a1 += (c1 / (1.f + __expf(-c1))) * w; }
          part[(0 * 16 + ks) * 32 + col] = a0; part[(1 * 16 + ks) * 32 + col] = a1;
          __syncthreads();
          if (tid < 64) { const int b = tid >> 5, cc = tid & 31; float s = A.b_ada[it * 32 + cc];
#pragma unroll
              for (int q = 0; q < 16; ++q) s += part[(b * 16 + q) * 32 + cc];
              mod[b * 6144 + it * 32 + cc] = s; }
          __syncthreads();
      } }
    { f32x2* tab = (f32x2*)(ws + WS_ROPE);
      for (int e = vcu * NTHR + tid; e < SEQ * 32; e += G * NTHR) { const int pos = e >> 5, i = e & 31; const float ang = (float)pos * A.freq[i]; float co, si; sincos_d((double)ang, co, si); tab[e] = (f32x2){co, si}; } }
    { LAS float* scr = (LAS float*)(lds + wave * 16384);
      const int gw = vcu * NWAVES + wave, NGW = G * NWAVES;
      constexpr int I_IN = (DM / 64) * (INC / 32), I_OUT = (DM / 64) * (DM / 32), I_G = (DM / 64) * (DFF / 32), I_D = (DFF / 64) * (DM / 32);
      constexpr int NITEMS = I_IN + I_OUT + 2 * I_G + I_D;
      for (int it = gw; it < NITEMS; it += NGW) {
          int r = it;
          if (r < I_IN) { p0_transpose_item(A.w_in, DM, INC, (bf16*)(ws + WS_WIN), 0, scr, r, lane); continue; } r -= I_IN;
          if (r < I_OUT) { p0_transpose_item(A.w_out, DM, DM, (bf16*)(ws + WS_WOUT), 1, scr, r, lane); continue; } r -= I_OUT;
          if (r < I_G) { p0_transpose_item(A.w_gate, DM, DFF, (bf16*)(ws + WS_WGU), 2, scr, r, lane); continue; } r -= I_G;
          if (r < I_G) { p0_transpose_item(A.w_up, DM, DFF, (bf16*)(ws + WS_WGU), 3, scr, r, lane); continue; } r -= I_G;
          p0_transpose_item(A.w_down, DFF, DM, (bf16*)(ws + WS_WD), 4, scr, r, lane);
      } }
}

__device__ __forceinline__ void p1_ln_mod(const Args& A, int lane, int gw, int NGW) {
    const float* mod = (const float*)(A.ws + WS_MOD); bf16* XN = (bf16*)(A.ws + WS_XN);
    for (int m = gw; m < M; m += NGW) {
        const int b = m / SEQ; const float* sh = mod + b * 6144, *sc = sh + 1024;
        const GAS f32x4* xr = (const GAS f32x4*)(A.x + (size_t)m * DM) + lane;
        f32x4 v[4]; float s = 0.f;
#pragma unroll
        for (int j = 0; j < 4; ++j) { v[j] = xr[64 * j]; s += (v[j].x + v[j].y) + (v[j].z + v[j].w); }
        const float mean = wave_sum(s) * (1.f / DM); float s2 = 0.f;
#pragma unroll
        for (int j = 0; j < 4; ++j) { v[j] = v[j] - mean; s2 += (v[j].x * v[j].x + v[j].y * v[j].y) + (v[j].z * v[j].z + v[j].w * v[j].w); }
        const float rstd = 1.f / sqrtf(wave_sum(s2) * (1.f / DM) + LN_EPS);
        GAS v2u* o8 = (GAS v2u*)(XN + (size_t)m * DM) + lane;
#pragma unroll
        for (int j = 0; j < 4; ++j) { const f32x4 a = *(const f32x4*)(sc + 4 * lane + 256 * j), d = *(const f32x4*)(sh + 4 * lane + 256 * j);
            const f32x4 y = v[j] * rstd * (a + 1.f) + d; o8[64 * j] = (v2u){pk2(y.x, y.y), pk2(y.z, y.w)}; }
    }
}
template <bool XN2> __device__ __forceinline__ void ln_affine_pass(const Args& A, const float* g, const float* bb, int lane, int gw, int NGW) {
    const float* mod = (const float*)(A.ws + WS_MOD); bf16* XN = (bf16*)(A.ws + WS_XN);
    for (int m = gw; m < M; m += NGW) {
        GAS f32x4* yr = (GAS f32x4*)(A.out + (size_t)m * DM) + lane;
        f32x4 v[4]; float s = 0.f;
#pragma unroll
        for (int j = 0; j < 4; ++j) { v[j] = yr[64 * j]; s += (v[j].x + v[j].y) + (v[j].z + v[j].w); }
        const float mean = wave_sum(s) * (1.f / DM); float s2 = 0.f;
#pragma unroll
        for (int j = 0; j < 4; ++j) { v[j] = v[j] - mean; s2 += (v[j].x * v[j].x + v[j].y * v[j].y) + (v[j].z * v[j].z + v[j].w * v[j].w); }
        const float rstd = 1.f / sqrtf(wave_sum(s2) * (1.f / DM) + LN_EPS);
        float t = 0.f;
#pragma unroll
        for (int j = 0; j < 4; ++j) { const f32x4 gg = *(const f32x4*)(g + 4 * lane + 256 * j), be = *(const f32x4*)(bb + 4 * lane + 256 * j);
            v[j] = v[j] * rstd * gg + be; yr[64 * j] = v[j]; t += (v[j].x + v[j].y) + (v[j].z + v[j].w); }
        if constexpr (XN2) {
            const int b = m / SEQ; const float* sh = mod + b * 6144 + 3072, *sc = sh + 1024;
            const float mean2 = wave_sum(t) * (1.f / DM); float t2 = 0.f;
#pragma unroll
            for (int j = 0; j < 4; ++j) { v[j] = v[j] - mean2; t2 += (v[j].x * v[j].x + v[j].y * v[j].y) + (v[j].z * v[j].z + v[j].w * v[j].w); }
            const float rstd2 = 1.f / sqrtf(wave_sum(t2) * (1.f / DM) + LN_EPS);
            GAS v2u* o8 = (GAS v2u*)(XN + (size_t)m * DM) + lane;
#pragma unroll
            for (int j = 0; j < 4; ++j) { const f32x4 a = *(const f32x4*)(sc + 4 * lane + 256 * j), d = *(const f32x4*)(sh + 4 * lane + 256 * j);
                const f32x4 y = v[j] * rstd2 * (a + 1.f) + d; o8[64 * j] = (v2u){pk2(y.x, y.y), pk2(y.z, y.w)}; }
        }
    }
}

struct FProj {
    unsigned char* wsb;
    __device__ __forceinline__ void operator()(int row, int col, f32x4 v, int pn) const {
        bf16* P = (bf16*)(wsb + WS_PROJ); const f32x2* tab = (const f32x2*)(wsb + WS_ROPE); unsigned char* kimg = wsb + WS_DAK; unsigned char* vimg = wsb + WS_DAV;
        if (pn >= 6 && pn < 10) {
            const int pos = row & (SEQ - 1), i = (col & 63) >> 1; const f32x2 c0 = tab[pos * 32 + i], c1 = tab[pos * 32 + i + 1];
            const float sc = (pn < 8) ? C2 : 1.f;
            const float a0 = (v.x * c0.x - v.y * c0.y) * sc, b0 = (v.y * c0.x + v.x * c0.y) * sc, a1 = (v.z * c1.x - v.w * c1.y) * sc, b1 = (v.w * c1.x + v.z * c1.y) * sc;
            v = (f32x4){a0, b0, a1, b1};
        }
        const v2u w = (v2u){pk2(v.x, v.y), pk2(v.z, v.w)};
        if (pn == 4 || pn == 5) { const int b = row / SEQ, s = row & (SEQ - 1), cc = col - O_NAV;
            bf16* vt = (bf16*)(wsb + WS_NAVT) + ((size_t)(b * 512 + cc)) * SEQ + s;
            vt[0] = (bf16)(w.x & 0xffffu); vt[SEQ] = (bf16)(w.x >> 16); vt[2 * SEQ] = (bf16)(w.y & 0xffffu); vt[3 * SEQ] = (bf16)(w.y >> 16); }
        else if (pn < 8) { *(GAS v2u*)(P + (size_t)row * INC + col) = w; }
        else {
            const int b = row / SEQ, s = row & (SEQ - 1), tile = s >> 6, k = s & 63;
            if (pn < 10) { const int cc = col - O_DAK, hm = cc >> 6, slot = cc & 63;
                *(GAS v2u*)(kimg + ((size_t)((b * 8 + hm) * 128 + tile)) * 8192 + (slot >> 3) * 1024 + k * 16 + (slot & 7) * 2) = w; }
            else { const int cc = col - O_DAV, h = cc >> 7, d = cc & 127;
                *(GAS v2u*)(vimg + ((size_t)((b * 4 + h) * 128 + tile)) * 16384 + ((k >> 3) * 4 + (d >> 5)) * 512 + (k & 7) * 64 + (d & 31) * 2) = w; }
        }
    }
};
struct FRes {
    const float* R; float* Y; const float* gate;
    __device__ __forceinline__ void operator()(int row, int col, f32x4 v, int) const {
        const int b = row / SEQ; const f32x4 r = *(const GAS f32x4*)(R + (size_t)row * DM + col), g = *(const f32x4*)(gate + b * 6144 + col);
        *(GAS f32x4*)(Y + (size_t)row * DM + col) = r * ALPHA + (g + 1.f) * v;
    }
};
struct FGU {
    bf16* H;
    __device__ __forceinline__ void operator()(int row, int col, f32x4 v, int) const {
        const float h0 = v.x / (1.f + __expf(-v.x)) * v.y, h1 = v.z / (1.f + __expf(-v.z)) * v.w;
        *(GAS unsigned*)(H + (size_t)row * DFF + (col >> 1)) = pk2(h0, h1);
    }
};

namespace na {
typedef short bf16x8 __attribute__((ext_vector_type(8)));
typedef __bf16 bf16x2_t __attribute__((ext_vector_type(2)));
__device__ __forceinline__ unsigned cvtpk(float lo, float hi) { f32x2 v = {lo, hi}; bf16x2_t b = __builtin_convertvector(v, bf16x2_t); return __builtin_bit_cast(unsigned, b); }
__device__ __forceinline__ void na_item(const Args& A, int b, int r, int h, int i, int lane) {
    const bf16* P = (const bf16*)(A.ws + WS_PROJ); const bf16* VT = (const bf16*)(A.ws + WS_NAVT);
    const int qq = lane & 15, g = lane >> 4, c = 16 * i + qq;
    int rs = r - NA_KR / 2; rs = rs < 0 ? 0 : (rs > ROWS - NA_KR ? ROWS - NA_KR : rs);
    int cs = c - NA_KC / 2; cs = cs < 0 ? 0 : (cs > GRID_W - NA_KC ? GRID_W - NA_KC : cs);
    int tcs = 16 * i - 8; tcs = tcs < 0 ? 0 : (tcs > 32 ? 32 : tcs);
    const size_t tok0 = (size_t)b * SEQ;
    const bf16* qrow = P + (tok0 + r * GRID_W + c) * INC + O_NAQ + h * 64 + 8 * g;
    const bf16x8 q0 = *(const GAS bf16x8*)(qrow), q1 = *(const GAS bf16x8*)(qrow + 32);
    f32x4 sc[8][2];
    const int kcol = tcs + 8 * (qq >> 2) + (qq & 3);
#pragma unroll
    for (int kr = 0; kr < 8; ++kr)
#pragma unroll
        for (int t = 0; t < 2; ++t) {
            const bf16* krow = P + (tok0 + (rs + kr) * GRID_W + kcol + 4 * t) * INC + O_NAK + h * 64 + 8 * g;
            const bf16x8 k0 = *(const GAS bf16x8*)(krow), k1 = *(const GAS bf16x8*)(krow + 32);
            f32x4 acc = (f32x4){0.f, 0.f, 0.f, 0.f};
            acc = __builtin_amdgcn_mfma_f32_16x16x32_bf16(k0, q0, acc, 0, 0, 0);
            acc = __builtin_amdgcn_mfma_f32_16x16x32_bf16(k1, q1, acc, 0, 0, 0);
            sc[kr][t] = acc; }
    const float* rpb = A.rpb + h * 15 * 31;
    float mx = -INFINITY;
#pragma unroll
    for (int kr = 0; kr < 8; ++kr)
#pragma unroll
        for (int t = 0; t < 2; ++t)
#pragma unroll
            for (int e = 0; e < 4; ++e) { const int kc = tcs + 8 * g + 4 * t + e; const bool valid = (kc >= cs) && (kc <= cs + NA_KC - 1);
                const int bi = valid ? (rs + kr - r + NA_KR - 1) * 31 + (kc - c + NA_KC - 1) : 0;
                const float s = valid ? sc[kr][t][e] * C2 + rpb[bi] * 1.4426950408889634f : -INFINITY;
                sc[kr][t][e] = s; mx = fmaxf(mx, s); }
    mx = fmaxf(mx, __shfl_xor(mx, 16)); mx = fmaxf(mx, __shfl_xor(mx, 32));
    float l = 0.f;
#pragma unroll
    for (int kr = 0; kr < 8; ++kr)
#pragma unroll
        for (int t = 0; t < 2; ++t)
#pragma unroll
            for (int e = 0; e < 4; ++e) { const float p = __builtin_amdgcn_exp2f(sc[kr][t][e] - mx); sc[kr][t][e] = p; l += p; }
    l += __shfl_xor(l, 16); l += __shfl_xor(l, 32);
    f32x4 o[4];
#pragma unroll
    for (int d = 0; d < 4; ++d) o[d] = (f32x4){0.f, 0.f, 0.f, 0.f};
    const bf16* vbase = VT + ((size_t)(b * 512 + h * 64 + qq)) * SEQ + rs * GRID_W + tcs + 8 * g;
#pragma unroll
    for (int kr = 0; kr < 8; ++kr) {
        const v4u w = {cvtpk(sc[kr][0][0], sc[kr][0][1]), cvtpk(sc[kr][0][2], sc[kr][0][3]), cvtpk(sc[kr][1][0], sc[kr][1][1]), cvtpk(sc[kr][1][2], sc[kr][1][3])};
        const bf16x8 pb = __builtin_bit_cast(bf16x8, w);
#pragma unroll
        for (int d = 0; d < 4; ++d) { const bf16x8 va = *(const GAS bf16x8*)(vbase + (size_t)(16 * d) * SEQ + kr * GRID_W);
            o[d] = __builtin_amdgcn_mfma_f32_16x16x32_bf16(va, pb, o[d], 0, 0, 0); } }
    const float il = 1.f / l;
    bf16* orow = (bf16*)(A.ws + WS_CAT) + (tok0 + r * GRID_W + c) * DM + h * 64 + 4 * g;
#pragma unroll
    for (int d = 0; d < 4; ++d) *(GAS v2u*)(orow + 16 * d) = (v2u){cvtpk(o[d].x * il, o[d].y * il), cvtpk(o[d].z * il, o[d].w * il)};
}
__device__ __forceinline__ void na_phase(const Args& A, int lane, int wave, int vcu, int G) {
    for (int w = vcu; w < BATCH * ROWS * 4; w += G) { const int b = w >> 9, r = (w >> 2) & 127, hp = w & 3; na_item(A, b, r, 2 * hp + (wave >> 2), wave & 3, lane); }
}
}

namespace da {
typedef short bf16x8 __attribute__((ext_vector_type(8)));
typedef short s16x4 __attribute__((ext_vector_type(4)));
typedef float f32x16 __attribute__((ext_vector_type(16)));
typedef __bf16 bf16x2_t __attribute__((ext_vector_type(2)));
constexpr int KSLOT = 8192, VSLOT = 16384, LDS_K = 0, LDS_V = 3 * KSLOT, NT = SEQ / 64;
constexpr float THRL = 8.f;
__device__ __forceinline__ unsigned cvtpk(float lo, float hi) { f32x2 v = {lo, hi}; bf16x2_t b = __builtin_convertvector(v, bf16x2_t); return __builtin_bit_cast(unsigned, b); }
#define DA_WAIT_BAR(N) asm volatile("s_waitcnt vmcnt(" #N ") lgkmcnt(0)\n\ts_barrier" ::: "memory")
#define DA_SBAR() __builtin_amdgcn_sched_barrier(0)
#define DA_PIN(x) asm volatile("" : "+v"(x))
#define DA_MX3(a, b, c) __builtin_fmaxf(__builtin_fmaxf((a), (b)), (c))
#define DA_EX(v) __builtin_amdgcn_exp2f(v)
#define DA_PKW(P, B) cvtpk(P[B], P[(B) + 1])
#define DA_LGKM(N) asm volatile("s_waitcnt lgkmcnt(" #N ")" ::: "memory")
#define DA_TR(dst, vb, OFF) asm volatile("ds_read_b64_tr_b16 %0, %1 offset:%2" : "=&v"(dst) : "v"(vb), "i"(OFF) : "memory")
#define DA_VFRAG(n) (bf16x8){vl[(n) % 3][0], vl[(n) % 3][1], vl[(n) % 3][2], vl[(n) % 3][3], vh[(n) % 3][0], vh[(n) % 3][1], vh[(n) % 3][2], vh[(n) % 3][3]}
#define DA_VRD(n, vb) do { DA_TR(vl[(n) % 3], vb, ((n) >> 2) * 4096 + ((n) & 3) * 512); DA_TR(vh[(n) % 3], vb, ((n) >> 2) * 4096 + 2048 + ((n) & 3) * 512); } while (0)

__device__ __forceinline__ void pv_tail(f32x16 (&o)[4], int vb, const v4u (&pw)[4]) {
    s16x4 vl[3], vh[3];
#define DA_T1(n) do { DA_VRD(n, vb); DA_LGKM(0); DA_SBAR(); o[(n) & 3] = __builtin_amdgcn_mfma_f32_32x32x16_bf16(DA_VFRAG(n), __builtin_bit_cast(bf16x8, pw[(n) >> 2]), o[(n) & 3], 0, 0, 0); DA_SBAR(); } while (0)
    DA_T1(0); DA_T1(1); DA_T1(2); DA_T1(3); DA_T1(4); DA_T1(5); DA_T1(6); DA_T1(7); DA_T1(8); DA_T1(9); DA_T1(10); DA_T1(11); DA_T1(12); DA_T1(13); DA_T1(14); DA_T1(15);
#undef DA_T1
}

__device__ __forceinline__ void da_unit(const Args& A, LAS unsigned char* lds, int unit, int tid, int lane, int wid) {
    const int b = unit >> 7, h = (unit >> 5) & 3, qb = unit & 31, r32 = lane & 31, hi = lane >> 5;
    const bf16* P = (const bf16*)(A.ws + WS_PROJ);
    const LAS unsigned char* kp0 = lds + LDS_K + hi * 1024 + r32 * 16;
    const int vb0 = (int)(unsigned)(size_t)(lds + LDS_V) + hi * 256 + ((lane >> 2) & 3) * 64 + ((lane >> 4) & 1) * 32 + (lane & 3) * 8;
    f32x16 o[4];
#pragma unroll 1
    for (int map = 0; map < 2; ++map) {
        const int hm = 2 * h + map;
        const unsigned char* kimg = A.ws + WS_DAK + (size_t)((b * 8 + hm) * 128) * 8192 + wid * 1024;
        const unsigned char* vimg = A.ws + WS_DAV + (size_t)((b * 4 + h) * 128) * 16384 + wid * 2048;
        const unsigned lane16 = (unsigned)lane * 16u;
#define DA_DMA_K(t, slot) __builtin_amdgcn_global_load_lds((const unsigned*)(kimg + (size_t)(t) * 8192 + lane16), (LAS unsigned*)(lds + LDS_K + (slot) * KSLOT + wid * 1024), 16, 0, 0)
#define DA_DMA_V(t, slot) do { __builtin_amdgcn_global_load_lds((const unsigned*)(vimg + (size_t)(t) * 16384 + lane16), (LAS unsigned*)(lds + LDS_V + (slot) * VSLOT + wid * 2048), 16, 0, 0); \
                               __builtin_amdgcn_global_load_lds((const unsigned*)(vimg + (size_t)(t) * 16384 + 1024 + lane16), (LAS unsigned*)(lds + LDS_V + (slot) * VSLOT + wid * 2048 + 1024), 16, 0, 0); } while (0)
        bf16x8 qr[4];
        { int r32o = r32, hio = hi; asm volatile("" : "+v"(r32o), "+v"(hio));
          const bf16* qrow = P + ((size_t)b * SEQ + qb * 256 + wid * 32 + r32o) * INC + O_DAQ + hm * 64 + hio * 8;
#pragma unroll
          for (int d0 = 0; d0 < 4; ++d0) qr[d0] = *(const GAS bf16x8*)(qrow + d0 * 16); }
        asm volatile("s_waitcnt vmcnt(0)" ::: "memory");
#pragma unroll
        for (int d0 = 0; d0 < 4; ++d0) o[d0] = (f32x16){};
        float mhat = 0.f, l_reg = 0.f, fres = 1.f; bool resc = false;
        f32x16 negm = (f32x16){}; DA_PIN(negm);
        f32x16 pA0, pA1, pB0, pB1; v4u pw[4];
        DA_DMA_K(0, 0); DA_DMA_K(1, 1); DA_DMA_V(0, 0);
        DA_WAIT_BAR(3);
        DA_DMA_K(2, 2); DA_DMA_V(1, 1);
        { bf16x8 kf[8];
#pragma unroll
          for (int i = 0; i < 4; ++i) { kf[2 * i] = *(const LAS bf16x8*)(kp0 + i * 2048); kf[2 * i + 1] = *(const LAS bf16x8*)(kp0 + i * 2048 + 512); }
          pA0 = __builtin_amdgcn_mfma_f32_32x32x16_bf16(kf[0], qr[0], negm, 0, 0, 0); pA1 = __builtin_amdgcn_mfma_f32_32x32x16_bf16(kf[1], qr[0], negm, 0, 0, 0);
#pragma unroll
          for (int i = 1; i < 4; ++i) { pA0 = __builtin_amdgcn_mfma_f32_32x32x16_bf16(kf[2 * i], qr[i], pA0, 0, 0, 0); pA1 = __builtin_amdgcn_mfma_f32_32x32x16_bf16(kf[2 * i + 1], qr[i], pA1, 0, 0, 0); }
          float rm = fmaxf(pA0[0], pA1[0]);
#pragma unroll
          for (int r = 1; r < 16; ++r) rm = fmaxf(rm, fmaxf(pA0[r], pA1[r]));
          { auto rr = __builtin_amdgcn_permlane32_swap(__float_as_uint(rm), __float_as_uint(rm), false, false); rm = fmaxf(__uint_as_float(rr[0]), __uint_as_float(rr[1])); }
          mhat = rm;
#pragma unroll
          for (int r = 0; r < 16; ++r) { pA0[r] = DA_EX(pA0[r] - rm); pA1[r] = DA_EX(pA1[r] - rm); negm[r] = -mhat; }
          DA_PIN(negm); }
        int s3 = 1;
#define DA_GAPA(MF, A0, A1, A2, A3, W0, W1, PW) do { MF; sacc += A0; sacc += A1; sacc += A2; sacc += A3; DA_PIN(sacc); W0; W1; DA_PIN(PW); DA_SBAR(); } while (0)
#define DA_GAPB(n, WN, X, B) do { if ((n) + 2 < 16) DA_VRD((n) + 2, vb); DA_LGKM(WN); DA_SBAR(); \
            o[(n) & 3] = __builtin_amdgcn_mfma_f32_32x32x16_bf16(DA_VFRAG(n), __builtin_bit_cast(bf16x8, pw[(n) >> 2]), o[(n) & 3], 0, 0, 0); \
            X[B] = DA_EX(X[B]); X[(B) + 1] = DA_EX(X[(B) + 1]); DA_PIN(X); DA_SBAR(); } while (0)
#define DA_STEP(C0, C1, P0, P1, j) do { \
            const int sn_ = (s3 == 2) ? 0 : s3 + 1, sp_ = (s3 == 0) ? 2 : s3 - 1; const int tk_ = ((j) + 2 < NT) ? (j) + 2 : NT - 1, tv_ = ((j) + 1 < NT) ? (j) + 1 : NT - 1; \
            DA_WAIT_BAR(3); \
            DA_DMA_K(tk_, sp_); DA_DMA_V(tv_, sn_); \
            const LAS unsigned char* kp_ = kp0 + s3 * KSLOT; const int vb = vb0 + sp_ * VSLOT; \
            bf16x8 ka_ = *(const LAS bf16x8*)(kp_), kb_ = *(const LAS bf16x8*)(kp_ + 512), kc_ = *(const LAS bf16x8*)(kp_ + 2048), kd_ = *(const LAS bf16x8*)(kp_ + 2560); \
            DA_SBAR(); float sacc = P0[0] + P0[1]; \
            DA_GAPA(C0 = __builtin_amdgcn_mfma_f32_32x32x16_bf16(ka_, qr[0], negm, 0, 0, 0); ka_ = *(const LAS bf16x8*)(kp_ + 4096), P0[2], P0[3], P0[4], P0[5],     pw[0][0] = DA_PKW(P0, 0),  pw[0][1] = DA_PKW(P0, 2),  pw[0]); \
            DA_GAPA(C1 = __builtin_amdgcn_mfma_f32_32x32x16_bf16(kb_, qr[0], negm, 0, 0, 0); kb_ = *(const LAS bf16x8*)(kp_ + 4608), P0[6], P0[7], P0[8], P0[9],     pw[0][2] = DA_PKW(P0, 4),  pw[0][3] = DA_PKW(P0, 6),  pw[0]); \
            DA_GAPA(C0 = __builtin_amdgcn_mfma_f32_32x32x16_bf16(kc_, qr[1], C0, 0, 0, 0);   kc_ = *(const LAS bf16x8*)(kp_ + 6144), P0[10], P0[11], P0[12], P0[13], pw[1][0] = DA_PKW(P0, 8),  pw[1][1] = DA_PKW(P0, 10), pw[1]); \
            DA_GAPA(C1 = __builtin_amdgcn_mfma_f32_32x32x16_bf16(kd_, qr[1], C1, 0, 0, 0);   kd_ = *(const LAS bf16x8*)(kp_ + 6656), P0[14], P0[15], P1[0], P1[1],   pw[1][2] = DA_PKW(P0, 12), pw[1][3] = DA_PKW(P0, 14), pw[1]); \
            DA_GAPA(C0 = __builtin_amdgcn_mfma_f32_32x32x16_bf16(ka_, qr[2], C0, 0, 0, 0),   P1[2], P1[3], P1[4], P1[5],     pw[2][0] = DA_PKW(P1, 0),  pw[2][1] = DA_PKW(P1, 2),  pw[2]); \
            DA_GAPA(C1 = __builtin_amdgcn_mfma_f32_32x32x16_bf16(kb_, qr[2], C1, 0, 0, 0),   P1[6], P1[7], P1[8], P1[9],     pw[2][2] = DA_PKW(P1, 4),  pw[2][3] = DA_PKW(P1, 6),  pw[2]); \
            DA_GAPA(C0 = __builtin_amdgcn_mfma_f32_32x32x16_bf16(kc_, qr[3], C0, 0, 0, 0),   P1[10], P1[11], P1[12], P1[13], pw[3][0] = DA_PKW(P1, 8),  pw[3][1] = DA_PKW(P1, 10), pw[3]); \
            DA_GAPA(C1 = __builtin_amdgcn_mfma_f32_32x32x16_bf16(kd_, qr[3], C1, 0, 0, 0),   P1[14], P1[15], 0.f, 0.f,       pw[3][2] = DA_PKW(P1, 12), pw[3][3] = DA_PKW(P1, 14), pw[3]); \
            l_reg += sacc; \
            s16x4 vl[3], vh[3]; DA_VRD(0, vb); DA_VRD(1, vb); \
            { float a_ = DA_MX3(C0[0], C0[1], C1[0]), b_ = DA_MX3(C0[2], C0[3], C1[1]); a_ = DA_MX3(a_, C1[2], C1[3]); \
              _Pragma("unroll") for (int r = 4; r < 16; r += 4) { a_ = DA_MX3(a_, C0[r], C0[r + 1]); b_ = DA_MX3(b_, C0[r + 2], C0[r + 3]); a_ = DA_MX3(a_, C1[r], C1[r + 1]); b_ = DA_MX3(b_, C1[r + 2], C1[r + 3]); } \
              float rm_ = __builtin_fmaxf(a_, b_); { auto rr = __builtin_amdgcn_permlane32_swap(__float_as_uint(rm_), __float_as_uint(rm_), false, false); rm_ = __builtin_fmaxf(__uint_as_float(rr[0]), __uint_as_float(rr[1])); } \
              resc = false; \
              if (__builtin_expect(__any(rm_ > THRL), 0)) { const float dl_ = __builtin_fmaxf(rm_, 0.f); mhat += dl_; \
                  _Pragma("unroll") for (int r = 0; r < 16; ++r) { C0[r] -= dl_; C1[r] -= dl_; } \
                  _Pragma("unroll") for (int r = 0; r < 16; ++r) negm[r] = -mhat; DA_PIN(negm); \
                  fres = DA_EX(-dl_); l_reg *= fres; resc = true; } } \
            DA_SBAR(); \
            DA_GAPB(0, 4, C0, 0);  DA_GAPB(1, 4, C0, 2);  DA_GAPB(2, 4, C0, 4);   DA_GAPB(3, 4, C0, 6);   DA_GAPB(4, 4, C0, 8);   DA_GAPB(5, 4, C0, 10);  DA_GAPB(6, 4, C0, 12);  DA_GAPB(7, 4, C0, 14); \
            DA_GAPB(8, 4, C1, 0);  DA_GAPB(9, 4, C1, 2);  DA_GAPB(10, 4, C1, 4);  DA_GAPB(11, 4, C1, 6);  DA_GAPB(12, 4, C1, 8);  DA_GAPB(13, 4, C1, 10); DA_GAPB(14, 2, C1, 12); DA_GAPB(15, 0, C1, 14); \
            if (resc) { _Pragma("unroll") for (int d_ = 0; d_ < 4; ++d_) o[d_] = o[d_] * fres; } \
            s3 = sn_; } while (0)
#pragma unroll 1
        for (int j = 1; j + 1 < NT; j += 2) {
            DA_STEP(pB0, pB1, pA0, pA1, j);
            DA_STEP(pA0, pA1, pB0, pB1, j + 1);
        }
        DA_STEP(pB0, pB1, pA0, pA1, NT - 1);
        { float sacc = 0.f;
#pragma unroll
          for (int r = 0; r < 16; ++r) sacc += pB0[r] + pB1[r];
          l_reg += sacc;
          pw[0] = (v4u){DA_PKW(pB0, 0), DA_PKW(pB0, 2), DA_PKW(pB0, 4), DA_PKW(pB0, 6)}; pw[1] = (v4u){DA_PKW(pB0, 8), DA_PKW(pB0, 10), DA_PKW(pB0, 12), DA_PKW(pB0, 14)};
          pw[2] = (v4u){DA_PKW(pB1, 0), DA_PKW(pB1, 2), DA_PKW(pB1, 4), DA_PKW(pB1, 6)}; pw[3] = (v4u){DA_PKW(pB1, 8), DA_PKW(pB1, 10), DA_PKW(pB1, 12), DA_PKW(pB1, 14)};
          DA_WAIT_BAR(0);
          DA_SBAR(); pv_tail(o, vb0 + ((s3 == 0) ? 2 : s3 - 1) * VSLOT, pw); }
        { auto rr = __builtin_amdgcn_permlane32_swap(__float_as_uint(l_reg), __float_as_uint(l_reg), false, false); l_reg = __uint_as_float(rr[0]) + __uint_as_float(rr[1]); }
        const float il = 1.f / l_reg;
        int tide = tid; asm volatile("" : "+v"(tide));
        const int lanee = tide & 63, hie = (tide >> 5) & 1;
        GAS f32x4* stash = (GAS f32x4*)(A.out) + (size_t)unit * 16 * NTHR + tide;
        if (map == 0) {
#pragma unroll
            for (int d0 = 0; d0 < 4; ++d0)
#pragma unroll
                for (int g = 0; g < 4; ++g) stash[(size_t)(d0 * 4 + g) * NTHR] = (f32x4){o[d0][4 * g] * il, o[d0][4 * g + 1] * il, o[d0][4 * g + 2] * il, o[d0][4 * g + 3] * il};
        } else {
            const float lam = __expf(wave_sum(A.lq1[lanee] * A.lk1[lanee])) - __expf(wave_sum(A.lq2[lanee] * A.lk2[lanee])) + LAMBDA_INIT;
            const float c2 = lam * il; float ss = 0.f;
#pragma unroll
            for (int d0 = 0; d0 < 4; ++d0)
#pragma unroll
                for (int g = 0; g < 4; ++g) { const f32x4 o1 = stash[(size_t)(d0 * 4 + g) * NTHR];
#pragma unroll
                    for (int e = 0; e < 4; ++e) { const float v = o1[e] - c2 * o[d0][4 * g + e]; o[d0][4 * g + e] = v; ss += v * v; } }
            { auto rr = __builtin_amdgcn_permlane32_swap(__float_as_uint(ss), __float_as_uint(ss), false, false); ss = __uint_as_float(rr[0]) + __uint_as_float(rr[1]); }
            const float rs = (1.f - LAMBDA_INIT) / sqrtf(ss * (1.f / 128.f) + LN_EPS);
            bf16* crow_p = (bf16*)(A.ws + WS_CAT) + ((size_t)b * SEQ + qb * 256 + wid * 32 + (lanee & 31)) * DM + 512 + h * 128 + 4 * hie;
#pragma unroll
            for (int d0 = 0; d0 < 4; ++d0)
#pragma unroll
                for (int g = 0; g < 4; ++g) { const int d = 32 * d0 + 8 * g; const f32x4 gg = *(const f32x4*)(A.subln_g + d + 4 * hie);
                    *(GAS v2u*)(crow_p + d) = (v2u){pk2(o[d0][4 * g] * rs * gg.x, o[d0][4 * g + 1] * rs * gg.y), pk2(o[d0][4 * g + 2] * rs * gg.z, o[d0][4 * g + 3] * rs * gg.w)}; }
        }
        asm volatile("s_waitcnt lgkmcnt(0)\n\ts_barrier" ::: "memory");
#undef DA_STEP
#undef DA_GAPA
#undef DA_GAPB
#undef DA_DMA_K
#undef DA_DMA_V
    }
}
}

__global__ void __launch_bounds__(NTHR, 2) fwd_kernel(Args A) {
    extern __shared__ __attribute__((aligned(16))) unsigned char lds_raw[];
    LAS unsigned char* lds = (LAS unsigned char*)lds_raw;
    const int tid = threadIdx.x, lane = tid & 63, wave = __builtin_amdgcn_readfirstlane(tid >> 6);
    const int G = gridDim.x; const int bx = blockIdx.x; const int vcu = (G % 8 == 0) ? (bx % 8) * (G / 8) + bx / 8 : bx;
    const int gw = vcu * NWAVES + wave, NGW = G * NWAVES;
    volatile LAS unsigned* MISC = (volatile LAS unsigned*)(lds + MISC_OFF);
    for (int u = tid; u < (LDS_BYTES - LDSCTL_OFF) / 4; u += NTHR) ((LAS unsigned*)(lds + LDSCTL_OFF))[u] = 0u;
    __syncthreads();
    unsigned* barw = (unsigned*)(A.ws + WS_CTL) + CW_BAR;
    XcdBarrier bar; bar.bar = barw; bar.x = 0; bar.st = nullptr;
    const int lo = A.ph_lo, hi = A.ph_hi;
    if (hi - lo > 1) bar = xcd_barrier_post(barw, MISC + 8);
#define IN(k) (lo <= (k) && (k) < hi)
#define SEAM(k) do { if (IN(k) && IN((k) + 1)) xcd_barrier(bar); } while (0)
    unsigned char* ws = A.ws;
    const float* mod = (const float*)(ws + WS_MOD);

    if (IN(0)) { p0_prologue(A, lds, tid, lane, wave, vcu, G); }
    SEAM(0);
    if (IN(1)) { p1_ln_mod(A, lane, gw, NGW); }
    SEAM(1);
    if (IN(2)) {
        pg8::Gemm g{(const bf16*)(ws + WS_XN), (const bf16*)(ws + WS_WIN), M, INC, DM}; pg8::StaticOrder S; S.init(M, INC, G, bx);
        pg8::EpiFn<FProj> E{FProj{ws}};
        pg8::gemm_phase<pg8::EpiFn<FProj>, pg8::StaticOrder, true, true>(lds, g, S, E);
    }
    SEAM(2);
    if (IN(3)) { na::na_phase(A, lane, wave, vcu, G); __syncthreads(); for (int u = vcu; u < 256; u += G) da::da_unit(A, lds, u, tid, lane, wave); }
    SEAM(3);
    if (IN(4)) {
        pg8::Gemm g{(const bf16*)(ws + WS_CAT), (const bf16*)(ws + WS_WOUT), M, DM, DM}; pg8::StaticOrder S; S.init(M, DM, G, bx);
        pg8::EpiFn<FRes> E{FRes{A.x, A.out, mod + 2048}};
        pg8::gemm_phase<pg8::EpiFn<FRes>, pg8::StaticOrder, true, true>(lds, g, S, E);
    }
    SEAM(4);
    if (IN(5)) { ln_affine_pass<true>(A, A.ln1_g, A.ln1_b, lane, gw, NGW); }
    SEAM(5);
    if (IN(6)) {
        pg8::Gemm g{(const bf16*)(ws + WS_XN), (const bf16*)(ws + WS_WGU), M, NGU, DM}; pg8::StaticOrder S; S.init(M, NGU, G, bx);
        pg8::EpiFn<FGU> E{FGU{(bf16*)(ws + WS_H)}};
        pg8::gemm_phase<pg8::EpiFn<FGU>, pg8::StaticOrder, true, true>(lds, g, S, E);
    }
    SEAM(6);
    if (IN(7)) {
        pg8::Gemm g{(const bf16*)(ws + WS_H), (const bf16*)(ws + WS_WD), M, DM, DFF}; pg8::StaticOrder S; S.init(M, DM, G, bx);
        pg8::EpiFn<FRes> E{FRes{A.out, A.out, mod + 5120}};
        pg8::gemm_phase<pg8::EpiFn<FRes>, pg8::StaticOrder, true, true>(lds, g, S, E);
    }
    SEAM(7);
    if (IN(8)) { ln_affine_pass<false>(A, A.ln2_g, A.ln2_b, lane, gw, NGW); }
#undef IN
#undef SEAM
}

extern "C" void kernel_launch(void* const* d_in, const int* in_sizes, int n_in, void* d_out, int out_size, void* d_ws, size_t ws_size, hipStream_t stream) {
    static int grid = 0;
    if (grid == 0) {
        if (n_in != 19 || in_sizes[0] != M * DM || out_size != M * DM || ws_size < WS_END) { fprintf(stderr, "kernel_launch: unexpected shapes (n_in %d, in0 %d, out %d, ws %zu)\n", n_in, n_in > 0 ? in_sizes[0] : -1, out_size, ws_size); grid = -1; return; }
        int dev = 0, cus = 0, per_cu = 0;
        if (hipGetDevice(&dev) != hipSuccess || hipDeviceGetAttribute(&cus, hipDeviceAttributeMultiprocessorCount, dev) != hipSuccess) { grid = -1; return; }
        if (hipFuncSetAttribute((const void*)fwd_kernel, hipFuncAttributeMaxDynamicSharedMemorySize, LDS_BYTES) != hipSuccess) { fprintf(stderr, "kernel_launch: hipFuncSetAttribute failed\n"); grid = -1; return; }
        if (hipOccupancyMaxActiveBlocksPerMultiprocessor(&per_cu, (const void*)fwd_kernel, NTHR, LDS_BYTES) != hipSuccess || per_cu < 1) { fprintf(stderr, "kernel_launch: occupancy query says %d blocks/CU\n", per_cu); (void)hipGetLastError(); grid = -1; return; }
        grid = cus;
    }
    if (grid < 0) return;
    Args a{};
    a.x = (const float*)d_in[0]; a.c = (const float*)d_in[1]; a.w_ada = (const float*)d_in[2]; a.b_ada = (const float*)d_in[3]; a.w_in = (const float*)d_in[4]; a.rpb = (const float*)d_in[5];
    a.lq1 = (const float*)d_in[6]; a.lk1 = (const float*)d_in[7]; a.lq2 = (const float*)d_in[8]; a.lk2 = (const float*)d_in[9]; a.subln_g = (const float*)d_in[10]; a.w_out = (const float*)d_in[11];
    a.ln1_g = (const float*)d_in[12]; a.ln1_b = (const float*)d_in[13]; a.w_gate = (const float*)d_in[14]; a.w_up = (const float*)d_in[15]; a.w_down = (const float*)d_in[16]; a.ln2_g = (const float*)d_in[17]; a.ln2_b = (const float*)d_in[18];
    a.out = (float*)d_out; a.ws = (unsigned char*)d_ws;
    for (int i = 0; i < 32; ++i) a.freq[i] = 1.0f / powf(10000.0f, (float)i / 32.0f);
    if (MK_N_LAUNCHES == 1) {
        if (hipMemsetAsync((char*)d_ws + WS_CTL, 0, CTL_ZERO_BYTES, stream) != hipSuccess) return;
        a.ph_lo = 0; a.ph_hi = N_PHASES;
        hipLaunchKernelGGL(fwd_kernel, dim3(grid), dim3(NTHR), LDS_BYTES, stream, a);
    } else {
        for (int p = 0; p < N_PHASES; ++p) { a.ph_lo = p; a.ph_hi = p + 1; hipLaunchKernelGGL(fwd_kernel, dim3(grid), dim3(NTHR), LDS_BYTES, stream, a); }
    }
    const hipError_t le = hipPeekAtLastError();
    if (le != hipSuccess) fprintf(stderr, "kernel_launch: launch failed: %s\n", hipGetErrorName(le));
}
```
